# Optimizing an MI355X kernel written in HIP

```python
import jax, jax.numpy as jnp
from jax import lax
import numpy as np

D_MODEL = 1024
BATCH = 4
SEQ = 4096
DEPTH = 4

GRID_W = 64
EPS = 1e-6
D_FF = 4 * D_MODEL
N_BRANCH = 4

HG_HEADS = 4
HG_DK = 128
HG_DV = (D_MODEL // 2) // HG_HEADS
HG_WIDTH = HG_HEADS * HG_DV
HG_KEY = HG_HEADS * HG_DK
HG_CHUNK = 16

NA_HEADS = 8
NA_DH = 64
NA_WIDTH = NA_HEADS * NA_DH
NA_ROWS = 8
NA_COLS = 16

LRU_WIDTH = D_MODEL // 2
LRU_BLOCKS = 8
LRU_BW = LRU_WIDTH // LRU_BLOCKS
LRU_CONV = 4
LRU_C = 8.0

SSD_INNER = D_MODEL
SSD_HEADDIM = 64
SSD_HEADS = SSD_INNER // SSD_HEADDIM
SSD_GROUPS = 4
SSD_STATE = 128
SSD_CONV = 4
SSD_CHUNK = 128
SSD_CONV_CH = SSD_INNER + 2 * SSD_GROUPS * SSD_STATE

IN_SIZES = (HG_KEY, HG_KEY, HG_KEY, HG_WIDTH, HG_WIDTH,
            NA_WIDTH, NA_WIDTH, NA_WIDTH,
            LRU_WIDTH, LRU_WIDTH,
            SSD_INNER, SSD_CONV_CH, 2 * SSD_HEADS,
            N_BRANCH * D_MODEL)
N_IN = sum(IN_SIZES)

kernel_name = "hybrid_hgrn2_natten_rglru_ssd_encoder"


def rmsnorm(x, g):
    x32 = x.astype(jnp.float32)
    y = x32 * lax.rsqrt(jnp.mean(x32 * x32, axis=-1, keepdims=True) + EPS)
    return y.astype(x.dtype) * g.astype(x.dtype)


def depthwise_conv(x, w, b):
    k_w, ch = w.shape
    left = k_w // 2
    y = lax.conv_general_dilated(x, w[:, None, :].astype(x.dtype), window_strides=(1,),
                                 padding=[(left, k_w - 1 - left)],
                                 dimension_numbers=('NWC', 'WIO', 'NWC'), feature_group_count=ch)
    return y + b.astype(x.dtype)


def _linear_combine(e1, e2):
    a1, u1 = e1
    a2, u2 = e2
    return a1 * a2, a2 * u1 + u2


def _gated_linear_scan(q, logf, k, v):
    bsz, s, h, dk = q.shape
    dv = v.shape[-1]
    n = s // HG_CHUNK

    def to_chunks(t):
        return t.reshape(bsz, n, HG_CHUNK, h, t.shape[-1]).transpose(1, 0, 3, 2, 4)

    causal = jnp.tril(jnp.ones((HG_CHUNK, HG_CHUNK), bool))

    def step(state, inp):
        qc, lfc, kc, vc = inp
        b = jnp.cumsum(lfc, axis=-2)
        diff = b[..., :, None, :] - b[..., None, :, :]
        dec = jnp.exp(jnp.where(causal[:, :, None], diff, -jnp.inf))
        scores = jnp.einsum('bhtk,bhsk,bhtsk->bhts', qc, kc, dec)
        o = (jnp.einsum('bhts,bhsv->bhtv', scores, vc)
             + jnp.einsum('bhtk,bhkv->bhtv', qc * jnp.exp(b), state))
        b_last = b[..., -1:, :]
        new_state = (state * jnp.exp(b_last[..., 0, :])[..., None]
                     + jnp.einsum('bhsk,bhsv->bhkv', kc * jnp.exp(b_last - b), vc))
        return new_state, o

    state0 = jnp.zeros((bsz, h, dk, dv), jnp.float32)
    _, o = lax.scan(step, state0, (to_chunks(q), to_chunks(logf), to_chunks(k), to_chunks(v)))
    return o.transpose(1, 0, 3, 2, 4).reshape(bsz, s, h, dv)


def hgrn2_mixer(q, zf_fwd, zf_bwd, i, g, lb_fwd, lb_bwd, norm_g):
    bsz, s, _ = q.shape

    def heads(t, d):
        return t.astype(jnp.float32).reshape(bsz, s, HG_HEADS, d)

    def forget(z, lb):
        z = z.astype(jnp.float32)
        lb = lb.astype(jnp.float32)
        logf = jnp.logaddexp(jnp.log(lb), jnp.log1p(-lb) + jax.nn.log_sigmoid(z))
        key = (1.0 - lb) * jax.nn.sigmoid(-z)
        return heads(logf, HG_DK), heads(key, HG_DK)

    qh = heads(q, HG_DK)
    vh = heads(i, HG_DV)
    lf_f, k_f = forget(zf_fwd, lb_fwd)
    lf_b, k_b = forget(zf_bwd, lb_bwd)
    o_f = _gated_linear_scan(qh, lf_f, k_f, vh)
    o_b = _gated_linear_scan(qh[:, ::-1], lf_b[:, ::-1], k_b[:, ::-1], vh[:, ::-1])[:, ::-1]
    o = o_f + o_b
    o = o * lax.rsqrt(jnp.mean(o * o, axis=-1, keepdims=True) + EPS)
    o = o.reshape(bsz, s, HG_WIDTH) * norm_g.astype(jnp.float32)
    return o * jax.nn.silu(g.astype(jnp.float32))


def neighbourhood_attention(q, k, v, rpb):
    bsz, s, h, dh = q.shape
    rows = s // GRID_W
    wr = min(NA_ROWS, rows)
    n_cb = GRID_W // NA_COLS
    kbw = min(2 * NA_COLS, GRID_W)
    r = np.arange(rows)
    krow = np.clip(r - NA_ROWS // 2, 0, rows - wr)[:, None] + np.arange(wr)[None, :]
    qcol = np.arange(n_cb)[:, None] * NA_COLS + np.arange(NA_COLS)[None, :]
    kcol = (np.clip(np.arange(n_cb) * NA_COLS - NA_COLS // 2, 0, GRID_W - kbw)[:, None]
            + np.arange(kbw)[None, :])
    cstart = np.clip(qcol - NA_COLS // 2, 0, GRID_W - NA_COLS)
    col_ok = ((kcol[:, None, :] >= cstart[:, :, None])
              & (kcol[:, None, :] < cstart[:, :, None] + NA_COLS))
    dr = krow - r[:, None] + NA_ROWS - 1
    dc = np.clip(kcol[:, None, :] - qcol[:, :, None], 1 - NA_COLS, NA_COLS - 1) + NA_COLS - 1
    bias = rpb.astype(jnp.float32)[:, dr[:, None, None, :, None], dc[None, :, :, None, :]]
    bias = jnp.where(col_ok[None, None, :, :, None, :], bias, -jnp.inf)
    key_idx = krow[:, None, :, None] * GRID_W + kcol[None, :, None, :]
    qb = q.reshape(bsz, rows, n_cb, NA_COLS, h, dh)
    kb = k[:, key_idx]
    vb = v[:, key_idx]
    sc = jnp.einsum('brmqhd,brmakhd->bhrmqak', qb, kb).astype(jnp.float32) * (dh ** -0.5) + bias[None]
    p = jax.nn.softmax(sc, axis=(-2, -1)).astype(v.dtype)
    o = jnp.einsum('bhrmqak,brmakhd->brmqhd', p, vb)
    return o.reshape(bsz, s, h * dh)


def rglru_mixer(xb, gate, conv_w, conv_b, gate_w, gate_b, lam):
    bsz, s, _ = xb.shape
    xf = depthwise_conv(xb, conv_w, conv_b).astype(jnp.float32)

    def direction(xs, w, b, lam_d):
        blk = xs.reshape(bsz, s, LRU_BLOCKS, LRU_BW)
        gates = (jnp.einsum('bsnd,gnde->gbsne', blk, w.astype(jnp.float32)).reshape(2, bsz, s, LRU_WIDTH)
                 + b.astype(jnp.float32)[:, None, None, :])
        rg = jax.nn.sigmoid(gates[0])
        ig = jax.nn.sigmoid(gates[1])
        log_a = -LRU_C * rg * jax.nn.softplus(-lam_d.astype(jnp.float32))
        a = jnp.exp(log_a)
        u = jnp.sqrt(-jnp.expm1(2.0 * log_a)) * (ig * xs)
        _, hs = lax.associative_scan(_linear_combine, (a, u), axis=1)
        return hs

    h_f = direction(xf, gate_w[0], gate_b[0], lam[0])
    h_b = direction(xf[:, ::-1], gate_w[1], gate_b[1], lam[1])[:, ::-1]
    return (h_f + h_b) * jax.nn.gelu(gate.astype(jnp.float32))


def _segsum(a):
    t = a.shape[-1]
    x = jnp.repeat(a[..., None], t, axis=-1)
    x = jnp.where(jnp.tril(jnp.ones((t, t), bool), -1), x, 0.0)
    sm = jnp.cumsum(x, axis=-2)
    return jnp.where(jnp.tril(jnp.ones((t, t), bool)), sm, -jnp.inf)


def _ssd_scan(x, dt, a_head, bm, cm):
    bsz, s, h, p = x.shape
    g, nst = bm.shape[2], bm.shape[3]
    rep = h // g
    q = SSD_CHUNK
    n = s // q
    xd = (x * dt[..., None]).reshape(bsz, n, q, g, rep, p)
    a = (dt * a_head).reshape(bsz, n, q, g, rep).transpose(0, 3, 4, 1, 2)
    bc = bm.reshape(bsz, n, q, g, nst)
    cc = cm.reshape(bsz, n, q, g, nst)
    a_cum = jnp.cumsum(a, axis=-1)
    lmat = jnp.exp(_segsum(a))
    cb = jnp.einsum('bnqgs,bnkgs->bgnqk', cc, bc)
    y_diag = jnp.einsum('bgnqk,bgrnqk,bnkgrp->bnqgrp', cb, lmat, xd)
    decay_states = jnp.exp(a_cum[..., -1:] - a_cum)
    states = jnp.einsum('bnkgs,bgrnk,bnkgrp->bngrps', bc, decay_states, xd)
    chunk_a = jnp.pad(a_cum[..., -1], ((0, 0), (0, 0), (0, 0), (1, 0)))
    decay_chunk = jnp.exp(_segsum(chunk_a))
    states = jnp.concatenate([jnp.zeros_like(states[:, :1]), states], axis=1)
    states = jnp.einsum('bgrzc,bcgrps->bzgrps', decay_chunk, states)[:, :-1]
    y_off = jnp.einsum('bnqgs,bngrps,bgrnq->bnqgrp', cc, states, jnp.exp(a_cum))
    return (y_diag + y_off).reshape(bsz, s, h, p)


def ssd_mixer(z, xbc, dt_raw, conv_w, conv_b, dt_bias, a_log, skip, norm_g):
    bsz, s, _ = z.shape
    xbc = jax.nn.silu(depthwise_conv(xbc, conv_w, conv_b)).astype(jnp.float32)
    xs, bm, cm = jnp.split(xbc, [SSD_INNER, SSD_INNER + SSD_GROUPS * SSD_STATE], axis=-1)
    xs = xs.reshape(bsz, s, SSD_HEADS, SSD_HEADDIM)
    bm = bm.reshape(bsz, s, SSD_GROUPS, SSD_STATE)
    cm = cm.reshape(bsz, s, SSD_GROUPS, SSD_STATE)
    dt = jax.nn.softplus(dt_raw.astype(jnp.float32).reshape(bsz, s, 2, SSD_HEADS) + dt_bias.astype(jnp.float32))
    a_head = -jnp.exp(a_log.astype(jnp.float32))
    y_f = _ssd_scan(xs, dt[:, :, 0], a_head[0], bm, cm)
    y_b = _ssd_scan(xs[:, ::-1], dt[:, ::-1, 1], a_head[1], bm[:, ::-1], cm[:, ::-1])[:, ::-1]
    y = y_f + y_b + skip.astype(jnp.float32)[:, None] * xs
    y = y.reshape(bsz, s, SSD_INNER) * jax.nn.silu(z.astype(jnp.float32))
    y = y * lax.rsqrt(jnp.mean(y * y, axis=-1, keepdims=True) + EPS)
    return y * norm_g.astype(jnp.float32)


def token_mixers(h, w_in, lb_fwd, lb_bwd, hg_norm, na_rpb, lru_conv_w, lru_conv_b, lru_gate_w, lru_gate_b,
                 lru_lambda, ssd_conv_w, ssd_conv_b, ssd_dt_bias, ssd_a_log, ssd_skip, ssd_norm,
                 w_br_hg, w_br_na, w_br_lru, w_br_ssd, w_out):
    bsz, s, _ = h.shape
    u = h @ w_in
    splits = np.cumsum(IN_SIZES)[:-1].tolist()
    (hg_q, hg_zf, hg_zb, hg_i, hg_g, na_q, na_k, na_v, lru_x, lru_g,
     ssd_z, ssd_xbc, ssd_dt, merge) = jnp.split(u, splits, axis=-1)
    y_hg = hgrn2_mixer(hg_q, hg_zf, hg_zb, hg_i, hg_g, lb_fwd, lb_bwd, hg_norm)
    y_na = neighbourhood_attention(na_q.reshape(bsz, s, NA_HEADS, NA_DH), na_k.reshape(bsz, s, NA_HEADS, NA_DH),
                                   na_v.reshape(bsz, s, NA_HEADS, NA_DH), na_rpb)
    y_lru = rglru_mixer(lru_x, lru_g, lru_conv_w, lru_conv_b, lru_gate_w, lru_gate_b, lru_lambda)
    y_ssd = ssd_mixer(ssd_z, ssd_xbc, ssd_dt, ssd_conv_w, ssd_conv_b, ssd_dt_bias, ssd_a_log, ssd_skip, ssd_norm)
    gt = jax.nn.sigmoid(merge.astype(jnp.float32)).astype(h.dtype).reshape(bsz, s, N_BRANCH, D_MODEL)
    merged = (gt[:, :, 0] * (y_hg.astype(h.dtype) @ w_br_hg)
              + gt[:, :, 1] * (y_na.astype(h.dtype) @ w_br_na)
              + gt[:, :, 2] * (y_lru.astype(h.dtype) @ w_br_lru)
              + gt[:, :, 3] * (y_ssd.astype(h.dtype) @ w_br_ssd))
    return merged @ w_out


def setup_inputs(seed: int = 0) -> dict:
    key = jax.random.key(seed)
    ks = iter(jax.random.split(key, 40))
    f32 = jnp.float32
    L = DEPTH

    def nrm(shape, scale):
        return jax.random.normal(next(ks), shape, f32) * scale

    x = nrm((BATCH, SEQ, D_MODEL), 1.0)
    c = nrm((BATCH, D_MODEL), 1.0)
    w_ada = nrm((L, D_MODEL, 6 * D_MODEL), 0.5 * D_MODEL ** -0.5)
    b_ada = nrm((L, 6 * D_MODEL), 0.02)
    g_mix = 1.0 + nrm((L, D_MODEL), 0.02)
    g_ffn = 1.0 + nrm((L, D_MODEL), 0.02)
    w_in = nrm((L, D_MODEL, N_IN), D_MODEL ** -0.5)
    hg_lb = nrm((2, L, HG_KEY), 0.5)
    hg_norm = 1.0 + nrm((L, HG_WIDTH), 0.02)
    na_rpb = nrm((L, NA_HEADS, 2 * NA_ROWS - 1, 2 * NA_COLS - 1), 0.1)
    lru_conv_w = nrm((L, LRU_CONV, LRU_WIDTH), LRU_CONV ** -0.5)
    lru_conv_b = nrm((L, LRU_WIDTH), 0.02)
    lru_gate_w = nrm((L, 2, 2, LRU_BLOCKS, LRU_BW, LRU_BW), LRU_BW ** -0.5)
    lru_gate_b = nrm((L, 2, 2, LRU_WIDTH), 0.02)
    a_pow = jax.random.uniform(next(ks), (L, 2, LRU_WIDTH), f32, minval=0.9, maxval=0.999)
    a0 = a_pow ** (1.0 / LRU_C)
    lru_lambda = jnp.log(a0) - jnp.log1p(-a0)
    ssd_conv_w = nrm((L, SSD_CONV, SSD_CONV_CH), SSD_CONV ** -0.5)
    ssd_conv_b = nrm((L, SSD_CONV_CH), 0.02)
    dt0 = jnp.exp(jax.random.uniform(next(ks), (L, 2, SSD_HEADS), f32,
                                     minval=float(np.log(1e-3)), maxval=float(np.log(1e-1))))
    ssd_dt_bias = dt0 + jnp.log(-jnp.expm1(-dt0))
    ssd_a_log = jnp.log(jax.random.uniform(next(ks), (L, 2, SSD_HEADS), f32, minval=1.0, maxval=16.0))
    ssd_skip = 1.0 + nrm((L, SSD_HEADS), 0.1)
    ssd_norm = 1.0 + nrm((L, SSD_INNER), 0.02)
    w_br_hg = nrm((L, HG_WIDTH, D_MODEL), HG_WIDTH ** -0.5)
    w_br_na = nrm((L, NA_WIDTH, D_MODEL), NA_WIDTH ** -0.5)
    w_br_lru = nrm((L, LRU_WIDTH, D_MODEL), LRU_WIDTH ** -0.5)
    w_br_ssd = nrm((L, SSD_INNER, D_MODEL), SSD_INNER ** -0.5)
    w_out = nrm((L, D_MODEL, D_MODEL), D_MODEL ** -0.5)
    w_ff1 = nrm((L, D_MODEL, D_FF), D_MODEL ** -0.5)
    w_ff2 = nrm((L, D_FF, D_MODEL), D_FF ** -0.5)
    g_final = 1.0 + nrm((D_MODEL,), 0.02)
    return {"x": x, "c": c, "w_ada": w_ada, "b_ada": b_ada, "g_mix": g_mix, "g_ffn": g_ffn, "w_in": w_in,
            "hg_lb": hg_lb, "hg_norm": hg_norm, "na_rpb": na_rpb,
            "lru_conv_w": lru_conv_w, "lru_conv_b": lru_conv_b, "lru_gate_w": lru_gate_w,
            "lru_gate_b": lru_gate_b, "lru_lambda": lru_lambda,
            "ssd_conv_w": ssd_conv_w, "ssd_conv_b": ssd_conv_b, "ssd_dt_bias": ssd_dt_bias,
            "ssd_a_log": ssd_a_log, "ssd_skip": ssd_skip, "ssd_norm": ssd_norm,
            "w_br_hg": w_br_hg, "w_br_na": w_br_na, "w_br_lru": w_br_lru, "w_br_ssd": w_br_ssd,
            "w_out": w_out, "w_ff1": w_ff1, "w_ff2": w_ff2, "g_final": g_final}


def reference(x, c, w_ada, b_ada, g_mix, g_ffn, w_in, hg_lb, hg_norm, na_rpb,
              lru_conv_w, lru_conv_b, lru_gate_w, lru_gate_b, lru_lambda,
              ssd_conv_w, ssd_conv_b, ssd_dt_bias, ssd_a_log, ssd_skip, ssd_norm,
              w_br_hg, w_br_na, w_br_lru, w_br_ssd, w_out, w_ff1, w_ff2, g_final):
    lb = jnp.cumsum(jax.nn.softmax(hg_lb.astype(jnp.float32), axis=1), axis=1)
    lb = lb - lb[:, :1]
    c_act = jax.nn.silu(c)
    for l in range(DEPTH):
        mod = (c_act @ w_ada[l] + b_ada[l])[:, None, :]
        shift_m, scale_m, gate_m, shift_f, scale_f, gate_f = jnp.split(mod.astype(x.dtype), 6, axis=-1)
        h = rmsnorm(x, g_mix[l]) * (1 + scale_m) + shift_m
        x = x + gate_m * token_mixers(h, w_in[l], lb[0, l], lb[1, l], hg_norm[l], na_rpb[l],
                                      lru_conv_w[l], lru_conv_b[l], lru_gate_w[l], lru_gate_b[l], lru_lambda[l],
                                      ssd_conv_w[l], ssd_conv_b[l], ssd_dt_bias[l], ssd_a_log[l], ssd_skip[l],
                                      ssd_norm[l], w_br_hg[l], w_br_na[l], w_br_lru[l], w_br_ssd[l], w_out[l])
        h = rmsnorm(x, g_ffn[l]) * (1 + scale_f) + shift_f
        x = x + gate_f * (jnp.square(jax.nn.relu(h @ w_ff1[l])) @ w_ff2[l])
    return rmsnorm(x, g_final)
```

```cpp
#include <hip/hip_runtime.h>
#include <hip/hip_cooperative_groups.h>
#include <cstdio>
#include <cstdint>
namespace cg = cooperative_groups;

#define DEVI __device__ __forceinline__
#define LAS __attribute__((address_space(3)))
#define LAUNDER(x) asm volatile("" : "+s"(x))
#define WSP char* ws_ = p.ws; LAUNDER(ws_)
#define TIDL int tid_ = threadIdx.x; asm volatile("" : "+v"(tid_))
typedef unsigned short bf16_t;
typedef short bf16x8 __attribute__((ext_vector_type(8)));
typedef short bf16x4 __attribute__((ext_vector_type(4)));
typedef float f32x4 __attribute__((ext_vector_type(4)));
typedef unsigned u32x4 __attribute__((ext_vector_type(4)));
typedef unsigned u32x2 __attribute__((ext_vector_type(2)));

constexpr int DM = 1024, NB = 4, SEQ = 4096, NT = NB * SEQ, NL = 4, NIN = 12320, LDU = 12544, DFF = 4096;
constexpr float EPS = 1e-6f;
constexpr int C_HGQ = 0, C_HGZF = 512, C_HGZB = 1024, C_HGI = 1536, C_HGG = 2048, C_NAQ = 2560, C_NAK = 3072, C_NAV = 3584,
              C_LRX = 4096, C_LRG = 4608, C_SSZ = 5120, C_SSX = 6144, C_SSB = 7168, C_SSC = 7680, C_SSDT = 8192, C_MRG = 8224;
constexpr int C_YHG = 0, C_OF = 512, C_OB = 1024, C_YNA = 2560, C_YLR = 4096, C_YSF = 6144, C_YSB = 7168;

constexpr size_t MiB = 1048576;
constexpr size_t O_BAR = 0;
constexpr size_t O_MOD = 4096;
constexpr size_t O_LBV = O_MOD + 4 * 4 * 6144 * 4;
constexpr size_t O_W = 1 * MiB;
constexpr size_t W_IN = 0, W_BRHG = W_IN + (size_t)LDU * 1024, W_BRNA = W_BRHG + 1024 * 512, W_BRLR = W_BRNA + 1024 * 512,
                 W_BRSS = W_BRLR + 1024 * 512, W_OUT = W_BRSS + 1024 * 1024, W_FF1 = W_OUT + 1024 * 1024, W_FF2 = W_FF1 + 4096 * 1024,
                 W_LRG = W_FF2 + 4096 * 1024, W_END = W_LRG + 32 * 4096;
constexpr size_t O_U = O_W + 49 * MiB;
constexpr size_t O_H = O_U + (size_t)NT * LDU * 2;
constexpr size_t O_QT = O_H + 32 * MiB;
constexpr size_t O_KC = O_QT + 32 * MiB;
constexpr size_t O_KT = O_KC + 32 * MiB;
constexpr size_t O_VT = O_KT + 32 * MiB;
constexpr size_t O_DEC = O_VT + 16 * MiB;
constexpr size_t O_VTN = O_DEC + 4 * MiB;
constexpr size_t O_HL = O_VTN + 16 * MiB;
constexpr size_t O_PP = O_HL + 32 * MiB;
constexpr size_t O_CP = O_PP + 32 * MiB;
constexpr size_t O_CH = O_CP + 1 * MiB;
constexpr size_t O_CIN = O_CH + 1 * MiB;
constexpr size_t O_XST = O_CIN + 1 * MiB;
constexpr size_t O_BM = O_XST + 32 * MiB;
constexpr size_t O_CM = O_BM + 16 * MiB;
constexpr size_t O_BT = O_CM + 16 * MiB;
constexpr size_t O_DT = O_BT + 16 * MiB;
constexpr size_t O_AA = O_DT + 2 * MiB;
constexpr size_t O_END = O_AA + 2 * MiB;
constexpr size_t O_MF32 = O_QT;
constexpr size_t O_HID = O_U;
static_assert(W_END * 2 <= 49 * MiB, "weights region");
static_assert(O_END <= 770 * MiB, "workspace");

struct Params {
  const float* in[29];
  float* X;
  char* ws;
};

DEVI float bf2f(bf16_t h) { return __uint_as_float((unsigned)h << 16); }
DEVI unsigned cvt_pk_bf16(float lo, float hi) { unsigned r; asm volatile("v_cvt_pk_bf16_f32 %0, %1, %2" : "=v"(r) : "v"(lo), "v"(hi)); return r; }
DEVI bf16_t f2bf(float f) { return (bf16_t)(cvt_pk_bf16(f, 0.f) & 0xffffu); }
DEVI float sigmoidf_(float x) { return 1.f / (1.f + __expf(-x)); }
DEVI float siluf_(float x) { return x / (1.f + __expf(-x)); }
DEVI float softplusf_(float x) { return x > 20.f ? x : log1pf(__expf(x)); }
DEVI float gelu_tanh(float x) { float u = 0.7978845608028654f * (x + 0.044715f * x * x * x); float e = __expf(2.f * u); float th = 1.f - 2.f / (e + 1.f); return 0.5f * x * (1.f + th); }
DEVI float wave_sum(float v) { for (int o = 32; o > 0; o >>= 1) v += __shfl_xor(v, o); return v; }
DEVI bf16x8 cat4(bf16x4 a, bf16x4 b) { return __builtin_shufflevector(a, b, 0, 1, 2, 3, 4, 5, 6, 7); }
DEVI bf16x4 pack4(f32x4 v) { u32x2 r; r.x = cvt_pk_bf16(v[0], v[1]); r.y = cvt_pk_bf16(v[2], v[3]); return __builtin_bit_cast(bf16x4, r); }
DEVI bf16x8 pack8(f32x4 a, f32x4 b) { u32x4 r; r.x = cvt_pk_bf16(a[0], a[1]); r.y = cvt_pk_bf16(a[2], a[3]); r.z = cvt_pk_bf16(b[0], b[1]); r.w = cvt_pk_bf16(b[2], b[3]); return __builtin_bit_cast(bf16x8, r); }
DEVI f32x4 mfma32(bf16x8 a, bf16x8 b, f32x4 c) { return __builtin_amdgcn_mfma_f32_16x16x32_bf16(a, b, c, 0, 0, 0); }
DEVI f32x4 mfma16(bf16x4 a, bf16x4 b, f32x4 c) { return __builtin_amdgcn_mfma_f32_16x16x16bf16_1k(a, b, c, 0, 0, 0); }
DEVI bf16x8 ld8(const bf16_t* p) { return *(const bf16x8*)p; }
DEVI bf16x4 ld4(const bf16_t* p) { return *(const bf16x4*)p; }

DEVI void gsync(unsigned* ctr, unsigned& epoch) {
  __syncthreads();
  epoch += gridDim.x;
  if (threadIdx.x == 0) {
    __threadfence();
    __hip_atomic_fetch_add(ctr, 1u, __ATOMIC_RELEASE, __HIP_MEMORY_SCOPE_AGENT);
    while (__hip_atomic_load(ctr, __ATOMIC_RELAXED, __HIP_MEMORY_SCOPE_AGENT) < epoch) __builtin_amdgcn_s_sleep(2);
    __threadfence();
  }
  __syncthreads();
  __builtin_amdgcn_fence(__ATOMIC_ACQUIRE, "agent");
}

constexpr int HTB = 128 * 64 * 2;
DEVI int lds_byte(int r, int c) { int st = (r >> 4) * 2 + (c >> 5), rr = r & 15, cc = c & 31, ob = rr * 64 + cc * 2; return st * 1024 + (ob ^ (((ob >> 9) & 1) << 5)); }
DEVI void stage_rc(int b, int& R, int& C) { int st = b / 1024, sb = b % 1024, swz = sb ^ (((sb >> 9) & 1) << 5); R = (st >> 1) * 16 + swz / 64; C = (st & 1) * 32 + (swz % 64) / 2; }

#define SA(b, h) (((b) * 2 + (h)) * HTB)
#define SB(b, h) ((4 + (b) * 2 + (h)) * HTB)
#define STAGE(bufoff, gbase, voff) do { _Pragma("unroll") for (int _i = 0; _i < 2; ++_i) \
    __builtin_amdgcn_global_load_lds((const unsigned*)((const char*)(gbase) + (voff)[_i]), (LAS unsigned*)(shm + (bufoff) + ldsw + _i * 8192), 16, 0, 0); } while (0)
#define LDA(dst, b, h) do { _Pragma("unroll") for (int m = 0; m < 4; ++m) _Pragma("unroll") for (int k = 0; k < 2; ++k) dst[m][k] = *(const LAS bf16x8*)(shm + SA(b, h) + aoff + m * 2048 + k * 1024); } while (0)
#define LDB(dst, b, h) do { _Pragma("unroll") for (int n = 0; n < 2; ++n) _Pragma("unroll") for (int k = 0; k < 2; ++k) dst[n][k] = *(const LAS bf16x8*)(shm + SB(b, h) + boff + n * 2048 + k * 1024); } while (0)
#define MMA(ai, bj, At_, Bt_) do { __builtin_amdgcn_s_setprio(1); \
    _Pragma("unroll") for (int m = 0; m < 4; ++m) _Pragma("unroll") for (int n = 0; n < 2; ++n) _Pragma("unroll") for (int k = 0; k < 2; ++k) \
      acc[ai][bj][m][n] = __builtin_amdgcn_mfma_f32_16x16x32_bf16(Bt_[n][k], At_[m][k], acc[ai][bj][m][n], 0, 0, 0); \
    __builtin_amdgcn_s_setprio(0); } while (0)
#define WAIT_V(n) asm volatile("s_waitcnt vmcnt(" #n ")" ::: "memory")
#define WAIT_L(n) asm volatile("s_waitcnt lgkmcnt(" #n ")" ::: "memory")
#define BAR __builtin_amdgcn_s_barrier()
#define SCHED __builtin_amdgcn_sched_barrier(0)

DEVI void gemm_tile(const bf16_t* A, int lda, const bf16_t* Bt, int ldb, int K, int brow, int bcol, f32x4 (&acc)[2][2][4][2], LAS char* shm) {
  TIDL; const int tid = tid_, wid = __builtin_amdgcn_readfirstlane(tid >> 6), lane = tid & 63, wr = wid >> 2, wc = wid & 3, fr = lane & 15, fq = lane >> 4;
#pragma unroll
  for (int a = 0; a < 2; ++a)
#pragma unroll
    for (int b = 0; b < 2; ++b)
#pragma unroll
      for (int m = 0; m < 4; ++m)
#pragma unroll
        for (int n = 0; n < 2; ++n) acc[a][b][m][n] = (f32x4){0.f, 0.f, 0.f, 0.f};
  unsigned voffA[2], voffB[2];
#pragma unroll
  for (int i = 0; i < 2; ++i) { int R, C; stage_rc(tid * 16 + i * 8192, R, C); voffA[i] = (unsigned)(R * lda + C) * 2u; voffB[i] = (unsigned)(R * ldb + C) * 2u; }
  const size_t kstep = 128, hstepA = (size_t)128 * lda * 2, hstepB = (size_t)128 * ldb * 2;
  const unsigned ldsw = (unsigned)wid * 1024u;
  const int aoff = lds_byte(wr * 64 + fr, fq * 8), boff = lds_byte(wc * 32 + fr, fq * 8);
  const char* cA = (const char*)A + (size_t)brow * lda * 2; const char* cB = (const char*)Bt + (size_t)bcol * ldb * 2;
  bf16x8 At[4][2], B0[2][2], B1[2][2];
  const int nt = K / 64;
  STAGE(SB(0, 0), cB, voffB); STAGE(SA(0, 0), cA, voffA); STAGE(SB(0, 1), cB + hstepB, voffB); STAGE(SA(0, 1), cA + hstepA, voffA);
  if (wr == 1) BAR;
  WAIT_V(4); BAR;
  STAGE(SB(1, 0), cB + kstep, voffB); STAGE(SA(1, 0), cA + kstep, voffA); STAGE(SB(1, 1), cB + hstepB + kstep, voffB);
  WAIT_V(6); BAR;
  for (int t = 0; t < nt - 2; t += 2) {
    const char* a1 = cA + (size_t)(t + 1) * kstep; const char* a2 = cA + (size_t)(t + 2) * kstep; const char* b2 = cB + (size_t)(t + 2) * kstep;
    const char* a3 = a2 + kstep; const char* b3 = b2 + kstep;
    LDB(B0, 0, 0); SCHED; LDA(At, 0, 0); STAGE(SA(1, 1), a1 + hstepA, voffA);
    WAIT_L(8); BAR; WAIT_L(0); MMA(0, 0, At, B0); BAR; SCHED;
    LDB(B1, 0, 1); STAGE(SB(0, 0), b2, voffB);
    BAR; WAIT_L(0); MMA(0, 1, At, B1); BAR;
    LDA(At, 0, 1); STAGE(SA(0, 0), a2, voffA);
    BAR; WAIT_L(0); MMA(1, 0, At, B0); BAR; SCHED;
    STAGE(SB(0, 1), b2 + hstepB, voffB);
    WAIT_V(6); BAR; MMA(1, 1, At, B1); BAR;
    LDB(B0, 1, 0); SCHED; LDA(At, 1, 0); STAGE(SA(0, 1), a2 + hstepA, voffA);
    WAIT_L(8); BAR; WAIT_L(0); MMA(0, 0, At, B0); BAR; SCHED;
    LDB(B1, 1, 1); STAGE(SB(1, 0), b3, voffB);
    BAR; WAIT_L(0); MMA(0, 1, At, B1); BAR;
    LDA(At, 1, 1); STAGE(SA(1, 0), a3, voffA);
    BAR; WAIT_L(0); MMA(1, 0, At, B0); BAR; SCHED;
    STAGE(SB(1, 1), b3 + hstepB, voffB);
    WAIT_V(6); BAR; MMA(1, 1, At, B1); BAR;
  }
  { const char* a1 = cA + (size_t)(nt - 1) * kstep;
    LDB(B0, 0, 0); LDA(At, 0, 0); STAGE(SA(1, 1), a1 + hstepA, voffA);
    BAR; WAIT_L(0); MMA(0, 0, At, B0); BAR;
    LDB(B1, 0, 1); BAR; WAIT_L(0); MMA(0, 1, At, B1); BAR;
    LDA(At, 0, 1); WAIT_V(4); BAR; WAIT_L(0); MMA(1, 0, At, B0); MMA(1, 1, At, B1); BAR; }
  { LDB(B0, 1, 0); LDA(At, 1, 0); WAIT_V(2); BAR; WAIT_L(0); MMA(0, 0, At, B0); BAR;
    LDB(B1, 1, 1); WAIT_V(0); BAR; WAIT_L(0); MMA(0, 1, At, B1); BAR;
    LDA(At, 1, 1); BAR; WAIT_L(0); MMA(1, 0, At, B0); MMA(1, 1, At, B1); BAR; }
  if (wr == 0) BAR;
}

DEVI void tile_of(int u, int nM, int nN, int& pm, int& pn) {
  const int nwg = nM * nN; int wgid = u;
  { const int q = nwg / 8, r = nwg % 8, xcd = wgid % 8, off = wgid / 8; wgid = (xcd < r ? xcd * (q + 1) : r * (q + 1) + (xcd - r) * q) + off; }
  const int nig = 8 * nN, gid = wgid / nig, fm = gid * 8, gsz = (nM - fm) < 8 ? (nM - fm) : 8;
  pm = fm + ((wgid % nig) % gsz); pn = (wgid % nig) / gsz;
}

#define EPI_LOOP(BODY) { TIDL; const int wid = __builtin_amdgcn_readfirstlane(tid_ >> 6), lane = tid_ & 63, wr = wid >> 2, wc = wid & 3, fr = lane & 15, fq = lane >> 4; \
  _Pragma("unroll") for (int ai = 0; ai < 2; ++ai) _Pragma("unroll") for (int m = 0; m < 4; ++m) { \
    int row = brow + ai * 128 + wr * 64 + m * 16 + fr; asm volatile("" : "+v"(row)); \
    _Pragma("unroll") for (int bj = 0; bj < 2; ++bj) _Pragma("unroll") for (int n = 0; n < 2; ++n) { \
      const int col = bcol + bj * 128 + wc * 32 + n * 16 + fq * 4; f32x4 v = acc[ai][bj][m][n]; BODY } asm volatile("" ::: "memory"); } }

DEVI void phase_mod(const Params& p, char* smem) {
  TIDL;
  WSP;
  float* cs = (float*)smem; float* red = cs + 4096;
  const float* c = p.in[1]; const float* w_ada = p.in[2]; const float* b_ada = p.in[3];
  float* mod = (float*)(ws_ + O_MOD);
  for (int i = tid_; i < 4096; i += 512) cs[i] = siluf_(c[i]);
  __syncthreads();
  const int col = tid_ & 63, kg = tid_ >> 6;
  for (int it = blockIdx.x; it < 4 * 96; it += gridDim.x) {
    const int l = it / 96, cb = it % 96, j = cb * 64 + col;
    const float* w = w_ada + (size_t)l * 1024 * 6144 + j;
    float a0 = 0, a1 = 0, a2 = 0, a3 = 0;
#pragma unroll 8
    for (int k = kg * 128; k < kg * 128 + 128; ++k) { const float wv = w[(size_t)k * 6144]; a0 += cs[k] * wv; a1 += cs[1024 + k] * wv; a2 += cs[2048 + k] * wv; a3 += cs[3072 + k] * wv; }
    red[(kg * 64 + col) * 4 + 0] = a0; red[(kg * 64 + col) * 4 + 1] = a1; red[(kg * 64 + col) * 4 + 2] = a2; red[(kg * 64 + col) * 4 + 3] = a3;
    __syncthreads();
    if (tid_ < 256) { const int c2 = tid_ & 63, b = tid_ >> 6; float s = 0;
      for (int g = 0; g < 8; ++g) s += red[(g * 64 + c2) * 4 + b];
      mod[(l * 4 + b) * 6144 + cb * 64 + c2] = s + b_ada[l * 6144 + cb * 64 + c2]; }
    __syncthreads();
  }
  if (blockIdx.x == gridDim.x - 1) {
    const float* hg_lb = p.in[7]; float* lbv = (float*)(ws_ + O_LBV);
    for (int i = tid_; i < 1024; i += 512) { const int dir = i >> 9, k = i & 511;
      float v[4], mx = -1e30f; for (int l = 0; l < 4; ++l) { v[l] = hg_lb[(dir * 4 + l) * 512 + k]; mx = fmaxf(mx, v[l]); }
      float s = 0; for (int l = 0; l < 4; ++l) { v[l] = __expf(v[l] - mx); s += v[l]; }
      float cum = 0; lbv[(dir * 4 + 0) * 512 + k] = 0.f;
      for (int l = 1; l < 4; ++l) { cum += v[l]; lbv[(dir * 4 + l) * 512 + k] = cum / s; } }
  }
}

DEVI void tconv_tile(const float* src, int K, int N, bf16_t* dst, int k0, int n0, float* tile) {
  TIDL;
  const int tid = tid_;
  { const int kr = tid >> 4, nc = (tid & 15) * 4;
#pragma unroll
    for (int i = 0; i < 2; ++i) { const int k = kr + i * 32; f32x4 v = (f32x4){0.f, 0.f, 0.f, 0.f};
      if (n0 + nc < N) v = *(const f32x4*)(src + (size_t)(k0 + k) * N + n0 + nc);
      tile[k * 65 + nc + 0] = v[0]; tile[k * 65 + nc + 1] = v[1]; tile[k * 65 + nc + 2] = v[2]; tile[k * 65 + nc + 3] = v[3]; } }
  __syncthreads();
  { const int n = tid >> 3, k8 = (tid & 7) * 8; u32x4 w;
    w.x = cvt_pk_bf16(tile[(k8 + 0) * 65 + n], tile[(k8 + 1) * 65 + n]); w.y = cvt_pk_bf16(tile[(k8 + 2) * 65 + n], tile[(k8 + 3) * 65 + n]);
    w.z = cvt_pk_bf16(tile[(k8 + 4) * 65 + n], tile[(k8 + 5) * 65 + n]); w.w = cvt_pk_bf16(tile[(k8 + 6) * 65 + n], tile[(k8 + 7) * 65 + n]);
    *(u32x4*)(dst + (size_t)(n0 + n) * K + k0 + k8) = w; }
  __syncthreads();
}

DEVI void phase_wconv(const Params& p, int l, char* smem) {
  WSP;
  float* tile = (float*)smem; bf16_t* W = (bf16_t*)(ws_ + O_W);
  for (int it = blockIdx.x; it < 6112; it += gridDim.x) {
    int i = it;
    if (i < 3136) { tconv_tile(p.in[6] + (size_t)l * 1024 * NIN, 1024, NIN, W + W_IN, (i / 196) * 64, (i % 196) * 64, tile); continue; } i -= 3136;
    if (i < 128) { tconv_tile(p.in[21] + (size_t)l * 512 * 1024, 512, 1024, W + W_BRHG, (i / 16) * 64, (i % 16) * 64, tile); continue; } i -= 128;
    if (i < 128) { tconv_tile(p.in[22] + (size_t)l * 512 * 1024, 512, 1024, W + W_BRNA, (i / 16) * 64, (i % 16) * 64, tile); continue; } i -= 128;
    if (i < 128) { tconv_tile(p.in[23] + (size_t)l * 512 * 1024, 512, 1024, W + W_BRLR, (i / 16) * 64, (i % 16) * 64, tile); continue; } i -= 128;
    if (i < 256) { tconv_tile(p.in[24] + (size_t)l * 1024 * 1024, 1024, 1024, W + W_BRSS, (i / 16) * 64, (i % 16) * 64, tile); continue; } i -= 256;
    if (i < 256) { tconv_tile(p.in[25] + (size_t)l * 1024 * 1024, 1024, 1024, W + W_OUT, (i / 16) * 64, (i % 16) * 64, tile); continue; } i -= 256;
    if (i < 1024) { tconv_tile(p.in[26] + (size_t)l * 1024 * 4096, 1024, 4096, W + W_FF1, (i / 64) * 64, (i % 64) * 64, tile); continue; } i -= 1024;
    if (i < 1024) { tconv_tile(p.in[27] + (size_t)l * 4096 * 1024, 4096, 1024, W + W_FF2, (i / 16) * 64, (i % 16) * 64, tile); continue; } i -= 1024;
    tconv_tile(p.in[12] + ((size_t)l * 32 + i) * 4096, 64, 64, W + W_LRG + (size_t)i * 4096, 0, 0, tile);
  }
}

DEVI void phase_norm(const float* src, float* xcopy, const float* g, const float* mod, int shift_off, int scale_off, bf16_t* H) {
  TIDL;
  const int wid = tid_ >> 6, lane = tid_ & 63;
  for (int row = blockIdx.x * 8 + wid; row < NT; row += gridDim.x * 8) {
    f32x4 v[4]; float ss = 0.f;
#pragma unroll
    for (int i = 0; i < 4; ++i) { v[i] = *(const f32x4*)(src + (size_t)row * DM + i * 256 + lane * 4); ss += v[i][0] * v[i][0] + v[i][1] * v[i][1] + v[i][2] * v[i][2] + v[i][3] * v[i][3]; }
    ss = wave_sum(ss); const float r = rsqrtf(ss * (1.f / DM) + EPS);
    const float* mb = mod + (row >> 12) * 6144;
#pragma unroll
    for (int i = 0; i < 4; ++i) { const int c = i * 256 + lane * 4;
      if (xcopy) *(f32x4*)(xcopy + (size_t)row * DM + c) = v[i];
      const f32x4 gg = *(const f32x4*)(g + c), sc = *(const f32x4*)(mb + scale_off + c), sh = *(const f32x4*)(mb + shift_off + c);
      f32x4 y; for (int j = 0; j < 4; ++j) y[j] = v[i][j] * r * gg[j] * (1.f + sc[j]) + sh[j];
      *(bf16x4*)(H + (size_t)row * DM + c) = pack4(y); }
  }
}

DEVI void phase_final_norm(float* X, const float* g) {
  TIDL;
  const int wid = tid_ >> 6, lane = tid_ & 63;
  for (int row = blockIdx.x * 8 + wid; row < NT; row += gridDim.x * 8) {
    f32x4 v[4]; float ss = 0.f;
#pragma unroll
    for (int i = 0; i < 4; ++i) { v[i] = *(const f32x4*)(X + (size_t)row * DM + i * 256 + lane * 4); ss += v[i][0] * v[i][0] + v[i][1] * v[i][1] + v[i][2] * v[i][2] + v[i][3] * v[i][3]; }
    ss = wave_sum(ss); const float r = rsqrtf(ss * (1.f / DM) + EPS);
#pragma unroll
    for (int i = 0; i < 4; ++i) { const int c = i * 256 + lane * 4; const f32x4 gg = *(const f32x4*)(g + c);
      f32x4 y; for (int j = 0; j < 4; ++j) y[j] = v[i][j] * r * gg[j];
      *(f32x4*)(X + (size_t)row * DM + c) = y; }
  }
}

DEVI void phase_hg_pre(const Params& p, int l) {
  TIDL;
  WSP;
  const bf16_t* U = (const bf16_t*)(ws_ + O_U);
  bf16_t* QT = (bf16_t*)(ws_ + O_QT); bf16_t* KC = (bf16_t*)(ws_ + O_KC); bf16_t* KT = (bf16_t*)(ws_ + O_KT); bf16_t* VT = (bf16_t*)(ws_ + O_VT);
  float* DEC = (float*)(ws_ + O_DEC); const float* lbv = (const float*)(ws_ + O_LBV);
  const int tid = tid_, h = tid >> 7, k = tid & 127;
  const float lb0 = lbv[(0 * 4 + l) * 512 + tid], lb1 = lbv[(1 * 4 + l) * 512 + tid];
  for (int it = blockIdx.x; it < NB * 256; it += gridDim.x) {
    const int b = it >> 8, c = it & 255; const size_t row0 = (size_t)b * SEQ + c * 16;
    float q[16], bc[16], kk[16];
#pragma unroll
    for (int t = 0; t < 16; ++t) q[t] = bf2f(U[(row0 + t) * LDU + C_HGQ + tid]);
    { unsigned vp[8];
#pragma unroll
      for (int t = 0; t < 16; t += 2) vp[t >> 1] = (unsigned)U[(row0 + t) * LDU + C_HGI + tid] | ((unsigned)U[(row0 + t + 1) * LDU + C_HGI + tid] << 16);
      bf16_t* d = VT + (((size_t)b * 4 + h) * 128 + k) * SEQ + c * 16;
      *(u32x4*)d = (u32x4){vp[0], vp[1], vp[2], vp[3]}; *(u32x4*)(d + 8) = (u32x4){vp[4], vp[5], vp[6], vp[7]}; }
#pragma unroll
    for (int dir = 0; dir < 2; ++dir) {
      const float lb = dir ? lb1 : lb0; float run = 0.f;
#pragma unroll
      for (int tt = 0; tt < 16; ++tt) { const int t = dir ? 15 - tt : tt;
        const float z = bf2f(U[(row0 + t) * LDU + (dir ? C_HGZB : C_HGZF) + tid]);
        float f = lb + (1.f - lb) * sigmoidf_(z); f = fmaxf(f, 1e-30f);
        run += __logf(f); bc[t] = run; kk[t] = 1.f - f; }
      const float tot = run;
      bf16_t* qd = QT + ((size_t)dir * NT + row0) * 512 + tid; bf16_t* kd = KC + ((size_t)dir * NT + row0) * 512 + tid;
      unsigned kp[8];
#pragma unroll
      for (int t = 0; t < 16; ++t) {
        qd[(size_t)t * 512] = f2bf(q[t] * __expf(bc[t]));
        kd[(size_t)t * 512] = f2bf(kk[t] * __expf(fminf(-bc[t], 80.f)));
      }
#pragma unroll
      for (int t = 0; t < 16; t += 2) kp[t >> 1] = cvt_pk_bf16(kk[t] * __expf(tot - bc[t]), kk[t + 1] * __expf(tot - bc[t + 1]));
      bf16_t* d = KT + ((((size_t)dir * NB + b) * 4 + h) * 128 + k) * SEQ + c * 16;
      *(u32x4*)d = (u32x4){kp[0], kp[1], kp[2], kp[3]}; *(u32x4*)(d + 8) = (u32x4){kp[4], kp[5], kp[6], kp[7]};
      DEC[(((size_t)dir * NB + b) * 256 + c) * 512 + tid] = __expf(tot);
    }
  }
}

DEVI void hg_scan_item(const Params& p, int item) {
  TIDL;
  WSP;
  const int dir = item & 1, h = (item >> 1) & 3, b = item >> 3;
  const int w = tid_ >> 6, lane = tid_ & 63, fr = lane & 15, fq = lane >> 4;
  bf16_t* U0 = (bf16_t*)(ws_ + O_U);
  const bf16_t* QT0 = (const bf16_t*)(ws_ + O_QT) + (size_t)dir * NT * 512 + h * 128;
  const bf16_t* KC0 = (const bf16_t*)(ws_ + O_KC) + (size_t)dir * NT * 512 + h * 128;
  const bf16_t* KT0 = (const bf16_t*)(ws_ + O_KT) + (((size_t)dir * NB + b) * 4 + h) * 128 * SEQ;
  const bf16_t* VT = (const bf16_t*)(ws_ + O_VT) + (((size_t)b * 4 + h) * 128 + w * 16 + fr) * SEQ;
  const float* DEC0 = (const float*)(ws_ + O_DEC) + ((size_t)dir * NB + b) * 256 * 512 + h * 128;
  f32x4 st[8];
#pragma unroll
  for (int i = 0; i < 8; ++i) st[i] = (f32x4){0.f, 0.f, 0.f, 0.f};
  const int ocol = (dir ? C_OB : C_OF) + h * 128 + w * 16 + fq * 4;
  for (int cc = 0; cc < 256; ++cc) { const bf16_t* QT = QT0; LAUNDER(QT); const bf16_t* KC = KC0; LAUNDER(KC); const bf16_t* KT = KT0; LAUNDER(KT); const float* DEC = DEC0; LAUNDER(DEC); bf16_t* U = U0; LAUNDER(U);
    const int c = dir ? 255 - cc : cc; const size_t row0 = (size_t)b * SEQ + c * 16;
    bf16x8 qf[4], kf[4];
#pragma unroll
    for (int i2 = 0; i2 < 4; ++i2) {
      const bf16_t* qp = QT + (row0 + fr) * 512 + i2 * 32 + fq * 4; qf[i2] = cat4(ld4(qp), ld4(qp + 16));
      const bf16_t* kp = KC + (row0 + fr) * 512 + i2 * 32 + fq * 4; kf[i2] = cat4(ld4(kp), ld4(kp + 16)); }
    const bf16x4 vf = ld4(VT + c * 16 + fq * 4);
    bf16x4 ktf[8]; f32x4 dc[8];
#pragma unroll
    for (int kt = 0; kt < 8; ++kt) { ktf[kt] = ld4(KT + (size_t)(kt * 16 + fr) * SEQ + c * 16 + fq * 4); dc[kt] = *(const f32x4*)(DEC + (size_t)c * 512 + kt * 16 + fq * 4); }
    f32x4 sc = (f32x4){0.f, 0.f, 0.f, 0.f};
#pragma unroll
    for (int i2 = 0; i2 < 4; ++i2) sc = mfma32(kf[i2], qf[i2], sc);
#pragma unroll
    for (int j = 0; j < 4; ++j) { const int s = fq * 4 + j, t = fr; const bool ok = dir ? (s >= t) : (s <= t); sc[j] = ok ? sc[j] : 0.f; }
    f32x4 o = (f32x4){0.f, 0.f, 0.f, 0.f};
    o = mfma16(vf, pack4(sc), o);
#pragma unroll
    for (int i2 = 0; i2 < 4; ++i2) o = mfma32(pack8(st[2 * i2], st[2 * i2 + 1]), qf[i2], o);
    *(bf16x4*)(U + (row0 + fr) * LDU + ocol) = pack4(o);
#pragma unroll
    for (int kt = 0; kt < 8; ++kt) { st[kt] = st[kt] * dc[kt]; st[kt] = mfma16(ktf[kt], vf, st[kt]); }
  }
}

DEVI void pre_tok64(const Params& p, int l, int item, char* smem) {
  TIDL;
  WSP;
  const int b = item >> 6, tile = item & 63; const int t0 = tile * 64; const size_t row0 = (size_t)b * SEQ + t0;
  const int tid = tid_, w = tid >> 6, lane = tid & 63, fr = lane & 15, fq = lane >> 4;
  const bf16_t* U = (const bf16_t*)(ws_ + O_U);
  { bf16_t* VTN = (bf16_t*)(ws_ + O_VTN) + (((size_t)b * 8 + (tid >> 6)) * 64 + (tid & 63)) * SEQ + t0;
    for (int t8 = 0; t8 < 64; t8 += 8) { unsigned v[4];
#pragma unroll
      for (int i = 0; i < 4; ++i) v[i] = (unsigned)U[(row0 + t8 + 2 * i) * LDU + C_NAV + tid] | ((unsigned)U[(row0 + t8 + 2 * i + 1) * LDU + C_NAV + tid] << 16);
      *(u32x4*)(VTN + t8) = (u32x4){v[0], v[1], v[2], v[3]}; } }
  { const float* cw = p.in[15] + (size_t)l * 4 * 2048; const float* cb = p.in[16] + (size_t)l * 2048;
    bf16_t* XST = (bf16_t*)(ws_ + O_XST); bf16_t* BM = (bf16_t*)(ws_ + O_BM); bf16_t* CM = (bf16_t*)(ws_ + O_CM); bf16_t* BT = (bf16_t*)(ws_ + O_BT);
    for (int pass = 0; pass < 4; ++pass) { const int ch = pass * 512 + tid;
      const float w0 = cw[ch], w1 = cw[2048 + ch], w2 = cw[4096 + ch], w3 = cw[6144 + ch], bias = cb[ch];
      auto ldx = [&](int t) -> float { const int tt = t0 + t; return (tt >= 0 && tt < SEQ) ? bf2f(U[((size_t)b * SEQ + tt) * LDU + C_SSX + ch]) : 0.f; };
      float xm2 = ldx(-2), xm1 = ldx(-1), x0 = ldx(0);
      bf16_t* tdst = nullptr;
      if (pass < 2) tdst = XST + (((size_t)b * 16 + (ch >> 6)) * 64 + (ch & 63)) * SEQ + t0;
      else if (pass == 2) tdst = BT + (((size_t)b * 4 + ((ch - 1024) >> 7)) * 128 + ((ch - 1024) & 127)) * SEQ + t0;
      for (int t8 = 0; t8 < 64; t8 += 8) { float y[8];
#pragma unroll
        for (int i = 0; i < 8; ++i) { const float x1 = ldx(t8 + i + 1); y[i] = siluf_(w0 * xm2 + w1 * xm1 + w2 * x0 + w3 * x1 + bias); xm2 = xm1; xm1 = x0; x0 = x1; }
        if (pass >= 2) { bf16_t* rd = (pass == 2 ? BM : CM) + (row0 + t8) * 512 + (ch - (pass == 2 ? 1024 : 1536));
#pragma unroll
          for (int i = 0; i < 8; ++i) rd[(size_t)i * 512] = f2bf(y[i]); }
        if (pass < 3) *(u32x4*)(tdst + t8) = (u32x4){cvt_pk_bf16(y[0], y[1]), cvt_pk_bf16(y[2], y[3]), cvt_pk_bf16(y[4], y[5]), cvt_pk_bf16(y[6], y[7])};
      } }
    if (tid < 32) { const int dir = tid >> 4, hh = tid & 15; const float bias = p.in[17][(l * 2 + dir) * 16 + hh], ah = -__expf(p.in[18][(l * 2 + dir) * 16 + hh]);
      float* DT = (float*)(ws_ + O_DT) + ((size_t)dir * NT + row0) * 16 + hh; float* AA = (float*)(ws_ + O_AA) + ((size_t)dir * NT + row0) * 16 + hh;
      for (int t = 0; t < 64; ++t) { const float dt = softplusf_(bf2f(U[(row0 + t) * LDU + C_SSDT + dir * 16 + hh]) + bias); DT[t * 16] = dt; AA[t * 16] = dt * ah; } }
  }
  { bf16_t* xt = (bf16_t*)smem;
    float* scr = (float*)(smem + 66560) + w * 2048;
    { const float* cw = p.in[10] + (size_t)l * 4 * 512; const float w0 = cw[tid], w1 = cw[512 + tid], w2 = cw[1024 + tid], w3 = cw[1536 + tid], bias = p.in[11][l * 512 + tid];
      auto ldx = [&](int t) -> float { const int tt = t0 + t; return (tt >= 0 && tt < SEQ) ? bf2f(U[((size_t)b * SEQ + tt) * LDU + C_LRX + tid]) : 0.f; };
      float xm2 = ldx(-2), xm1 = ldx(-1), x0 = ldx(0);
      for (int t = 0; t < 64; ++t) { const float x1 = ldx(t + 1); xt[t * 520 + tid] = f2bf(w0 * xm2 + w1 * xm1 + w2 * x0 + w3 * x1 + bias); xm2 = xm1; xm1 = x0; x0 = x1; } }
    __syncthreads();
    const bf16_t* WG = (const bf16_t*)(ws_ + O_W) + W_LRG;
    _Float16* HL = (_Float16*)(ws_ + O_HL); _Float16* PP = (_Float16*)(ws_ + O_PP);
    const int n = w;
    for (int dir = 0; dir < 2; ++dir) {
      bf16x8 wf[2][4][2];
#pragma unroll
      for (int g = 0; g < 2; ++g)
#pragma unroll
        for (int nt_ = 0; nt_ < 4; ++nt_)
#pragma unroll
          for (int ks = 0; ks < 2; ++ks) wf[g][nt_][ks] = ld8(WG + ((((size_t)dir * 2 + g) * 8 + n) * 64 + nt_ * 16 + fr) * 64 + ks * 32 + fq * 8);
      float gbr[4], gbi[4], sp[4];
#pragma unroll
      for (int nt_ = 0; nt_ < 4; ++nt_) { const int ch = n * 64 + nt_ * 16 + fr;
        gbr[nt_] = p.in[13][((l * 2 + dir) * 2 + 0) * 512 + ch]; gbi[nt_] = p.in[13][((l * 2 + dir) * 2 + 1) * 512 + ch];
        sp[nt_] = softplusf_(-p.in[14][(l * 2 + dir) * 512 + ch]); }
      float hrun = 0.f, prun = 1.f;
      for (int mm = 0; mm < 4; ++mm) { const int mi = dir ? 3 - mm : mm;
        bf16x8 af[2];
#pragma unroll
        for (int ks = 0; ks < 2; ++ks) af[ks] = *(const bf16x8*)(xt + (mi * 16 + fr) * 520 + n * 64 + ks * 32 + fq * 8);
#pragma unroll
        for (int nt_ = 0; nt_ < 4; ++nt_) {
          f32x4 ar = (f32x4){0.f, 0.f, 0.f, 0.f}, ai_ = (f32x4){0.f, 0.f, 0.f, 0.f};
#pragma unroll
          for (int ks = 0; ks < 2; ++ks) { ar = mfma32(af[ks], wf[0][nt_][ks], ar); ai_ = mfma32(af[ks], wf[1][nt_][ks], ai_); }
#pragma unroll
          for (int j = 0; j < 4; ++j) { const int tl = fq * 4 + j, e = nt_ * 16 + fr;
            const float xv = bf2f(xt[(mi * 16 + tl) * 520 + n * 64 + e]);
            const float rg = sigmoidf_(ar[j] + gbr[nt_]), ig = sigmoidf_(ai_[j] + gbi[nt_]);
            const float la = -8.f * rg * sp[nt_]; const float a = __expf(la);
            const float mult = sqrtf(fmaxf(-expm1f(2.f * la), 0.f));
            scr[tl * 64 + e] = a; scr[1024 + tl * 64 + e] = mult * ig * xv; }
        }
        __builtin_amdgcn_wave_barrier(); asm volatile("s_waitcnt lgkmcnt(0)" ::: "memory");
        for (int t2 = 0; t2 < 16; ++t2) { const int tl = dir ? 15 - t2 : t2;
          const float a = scr[tl * 64 + lane], u = scr[1024 + tl * 64 + lane];
          hrun = a * hrun + u; prun *= a;
          const size_t o = ((size_t)dir * NT + row0 + mi * 16 + tl) * 512 + n * 64 + lane;
          HL[o] = (_Float16)hrun; PP[o] = (_Float16)prun; }
        __builtin_amdgcn_wave_barrier(); asm volatile("s_waitcnt lgkmcnt(0)" ::: "memory");
      }
      const size_t co = (((size_t)dir * NB + b) * 64 + tile) * 512 + n * 64 + lane;
      ((float*)(ws_ + O_CP))[co] = prun; ((float*)(ws_ + O_CH))[co] = hrun;
    }
    __syncthreads();
  }
}

DEVI void lru_carry_item(const Params& p, int item) {
  TIDL;
  WSP;
  const int g = item * 512 + tid_; const int dir = g >> 11, b = (g >> 9) & 3, ch = g & 511;
  const float* CP = (const float*)(ws_ + O_CP); const float* CH = (const float*)(ws_ + O_CH); float* CIN = (float*)(ws_ + O_CIN);
  float run = 0.f;
  for (int i = 0; i < 64; ++i) { const int tile = dir ? 63 - i : i; const size_t o = (((size_t)dir * NB + b) * 64 + tile) * 512 + ch;
    CIN[o] = run; run = CP[o] * run + CH[o]; }
}

DEVI void ssd_scan_item(const Params& p, int l, int item, char* smem) {
  TIDL;
  WSP;
  const int dir = item & 1, hh = (item >> 1) & 15, b = item >> 5, g = hh >> 2;
  const int tid = tid_, w = tid >> 6, lane = tid & 63, fr = lane & 15, fq = lane >> 4;
  bf16_t* U0 = (bf16_t*)(ws_ + O_U);
  const bf16_t* XST0 = (const bf16_t*)(ws_ + O_XST) + ((size_t)b * 16 + hh) * 64 * SEQ;
  const bf16_t* BM0 = (const bf16_t*)(ws_ + O_BM) + g * 128; const bf16_t* CM0 = (const bf16_t*)(ws_ + O_CM) + g * 128;
  const bf16_t* BT0 = (const bf16_t*)(ws_ + O_BT) + ((size_t)b * 4 + g) * 128 * SEQ;
  const float* DT0 = (const float*)(ws_ + O_DT) + (size_t)dir * NT * 16 + hh; const float* AA0 = (const float*)(ws_ + O_AA) + (size_t)dir * NT * 16 + hh;
  const float skip = p.in[19][l * 16 + hh];
  float* acum = (float*)smem;
  float* wgt = acum + 256;
  float* dtv = wgt + 256;
  float* tot = dtv + 256;
  bf16_t* stl = (bf16_t*)(smem + 4096);
  for (int i = tid; i < 64 * 136; i += 512) stl[i] = 0;
  f32x4 stT[4];
#pragma unroll
  for (int i = 0; i < 4; ++i) stT[i] = (f32x4){0.f, 0.f, 0.f, 0.f};
  for (int nn = 0; nn < 32; ++nn) { const bf16_t* XST = XST0; LAUNDER(XST); const bf16_t* BM = BM0; LAUNDER(BM); const bf16_t* CM = CM0; LAUNDER(CM); const bf16_t* BT = BT0; LAUNDER(BT); bf16_t* U = U0; LAUNDER(U); const float* DT = DT0; LAUNDER(DT); const float* AA = AA0; LAUNDER(AA);
    const int n = dir ? 31 - nn : nn, par = nn & 1; const size_t row0 = (size_t)b * SEQ + n * 128; const int tc0 = n * 128;
    if (w == 0) {
      const float a0 = AA[(row0 + 2 * lane) * 16], a1 = AA[(row0 + 2 * lane + 1) * 16];
      const float d0 = DT[(row0 + 2 * lane) * 16], d1 = DT[(row0 + 2 * lane + 1) * 16];
      float s = a0 + a1, inc = s;
      for (int o = 1; o < 64; o <<= 1) { const float t = __shfl_up(inc, o); if (lane >= o) inc += t; }
      const float total = __shfl(inc, 63); const float exc = inc - s;
      float c0, c1;
      if (!dir) { c0 = exc + a0; c1 = exc + a0 + a1; } else { c0 = total - exc; c1 = total - exc - a0; }
      acum[par * 128 + 2 * lane] = c0; acum[par * 128 + 2 * lane + 1] = c1;
      wgt[par * 128 + 2 * lane] = __expf(total - c0) * d0; wgt[par * 128 + 2 * lane + 1] = __expf(total - c1) * d1;
      dtv[par * 128 + 2 * lane] = d0; dtv[par * 128 + 2 * lane + 1] = d1;
      if (lane == 0) tot[par] = total;
    }
    __syncthreads();
    const float* ac = acum + par * 128; const float* wg = wgt + par * 128; const float* dv = dtv + par * 128;
    int q = w * 16 + fr; asm volatile("" : "+v"(q)); const float acq = ac[q];
    bf16x8 cf[4];
#pragma unroll
    for (int ks = 0; ks < 4; ++ks) cf[ks] = ld8(CM + (row0 + q) * 512 + ks * 32 + fq * 8);
    bf16x8 mf[4];
#pragma unroll
    for (int c2 = 0; c2 < 4; ++c2) {
      f32x4 mt[2];
#pragma unroll
      for (int hf = 0; hf < 2; ++hf) { const int kt = 2 * c2 + hf; mt[hf] = (f32x4){0.f, 0.f, 0.f, 0.f};
        const bool need = dir ? (kt >= w) : (kt <= w);
        if (need) {
#pragma unroll
          for (int ks = 0; ks < 4; ++ks) mt[hf] = mfma32(ld8(BM + (row0 + kt * 16 + fr) * 512 + ks * 32 + fq * 8), cf[ks], mt[hf]);
#pragma unroll
          for (int j = 0; j < 4; ++j) { const int k = kt * 16 + fq * 4 + j; const bool ok = dir ? (k >= q) : (k <= q);
            mt[hf][j] = ok ? mt[hf][j] * __expf(acq - ac[k]) * dv[k] : 0.f; }
        } }
      mf[c2] = pack8(mt[0], mt[1]);
    }
    f32x4 y[4];
#pragma unroll
    for (int pt = 0; pt < 4; ++pt) { y[pt] = (f32x4){0.f, 0.f, 0.f, 0.f};
#pragma unroll
      for (int ks = 0; ks < 4; ++ks) y[pt] = mfma32(*(const bf16x8*)(stl + (pt * 16 + fr) * 136 + ks * 32 + fq * 8), cf[ks], y[pt]); }
    const float eq = __expf(acq);
#pragma unroll
    for (int pt = 0; pt < 4; ++pt) y[pt] = y[pt] * eq;
#pragma unroll
    for (int c2 = 0; c2 < 4; ++c2) {
      const bool need = dir ? (2 * c2 + 1 >= w) : (2 * c2 <= w);
      if (need) {
#pragma unroll
        for (int pt = 0; pt < 4; ++pt) { const bf16_t* xp = XST + (size_t)(pt * 16 + fr) * SEQ + tc0 + c2 * 32 + fq * 4;
          y[pt] = mfma32(cat4(ld4(xp), ld4(xp + 16)), mf[c2], y[pt]); } } }
#pragma unroll
    for (int pt = 0; pt < 4; ++pt) { f32x4 v = y[pt];
      if (!dir) {
#pragma unroll
        for (int j = 0; j < 4; ++j) v[j] += skip * bf2f(XST[(size_t)(pt * 16 + fq * 4 + j) * SEQ + tc0 + q]); }
      *(bf16x4*)(U + (row0 + q) * LDU + (dir ? C_YSB : C_YSF) + hh * 64 + pt * 16 + fq * 4) = pack4(v); }
    const float et = __expf(tot[par]);
#pragma unroll
    for (int pt = 0; pt < 4; ++pt) stT[pt] = stT[pt] * et;
#pragma unroll
    for (int ks = 0; ks < 4; ++ks) {
      const bf16x8 braw = ld8(BT + (size_t)(w * 16 + fr) * SEQ + tc0 + ks * 32 + fq * 8);
      f32x4 lo, hi;
#pragma unroll
      for (int i = 0; i < 4; ++i) { lo[i] = bf2f((bf16_t)braw[i]) * wg[ks * 32 + fq * 8 + i]; hi[i] = bf2f((bf16_t)braw[4 + i]) * wg[ks * 32 + fq * 8 + 4 + i]; }
      const bf16x8 bw = pack8(lo, hi);
#pragma unroll
      for (int pt = 0; pt < 4; ++pt) stT[pt] = mfma32(bw, ld8(XST + (size_t)(pt * 16 + fr) * SEQ + tc0 + ks * 32 + fq * 8), stT[pt]);
    }
    __syncthreads();
#pragma unroll
    for (int pt = 0; pt < 4; ++pt) *(bf16x4*)(stl + (pt * 16 + fr) * 136 + w * 16 + fq * 4) = pack4(stT[pt]);
  }
  __syncthreads();
}

DEVI void na_item(const Params& p, int l, int item) {
  TIDL;
  WSP;
  const int w = tid_ >> 6, lane = tid_ & 63, fr = lane & 15, fq = lane >> 4;
  const int m = item & 3, r = (item >> 2) & 63, b = item >> 8, hd = w;
  bf16_t* U = (bf16_t*)(ws_ + O_U);
  const bf16_t* VTN = (const bf16_t*)(ws_ + O_VTN) + ((size_t)b * 8 + hd) * 64 * SEQ;
  const float* rpb = p.in[9] + ((size_t)l * 8 + hd) * 15 * 31;
  int kr0 = r - 4; kr0 = kr0 < 0 ? 0 : (kr0 > 56 ? 56 : kr0);
  int kc0 = m * 16 - 8; kc0 = kc0 < 0 ? 0 : (kc0 > 32 ? 32 : kc0);
  const size_t qrow = (size_t)b * SEQ + r * 64 + m * 16 + fr;
  bf16x8 qf[2];
#pragma unroll
  for (int ks = 0; ks < 2; ++ks) qf[ks] = ld8(U + qrow * LDU + C_NAQ + hd * 64 + ks * 32 + fq * 8);
  const int qcol = m * 16 + fr; int cst = qcol - 8; cst = cst < 0 ? 0 : (cst > 48 ? 48 : cst);
  f32x4 s[16]; float mx = -1e30f;
#pragma unroll
  for (int a = 0; a < 8; ++a)
#pragma unroll
    for (int hf = 0; hf < 2; ++hf) { const int ti = a * 2 + hf;
      const size_t krow = (size_t)b * SEQ + (kr0 + a) * 64 + kc0 + hf * 16 + fr;
      f32x4 acc = (f32x4){0.f, 0.f, 0.f, 0.f};
#pragma unroll
      for (int ks = 0; ks < 2; ++ks) acc = mfma32(ld8(U + krow * LDU + C_NAK + hd * 64 + ks * 32 + fq * 8), qf[ks], acc);
      const int dr = kr0 + a - r + 7;
#pragma unroll
      for (int j = 0; j < 4; ++j) { const int kcol = kc0 + hf * 16 + fq * 4 + j; const bool ok = (kcol >= cst) && (kcol < cst + 16);
        int dcc = kcol - qcol; dcc = dcc < -15 ? -15 : (dcc > 15 ? 15 : dcc);
        const float v = ok ? acc[j] * 0.125f + rpb[dr * 31 + dcc + 15] : -1e30f; acc[j] = v; mx = fmaxf(mx, v); }
      s[ti] = acc; }
  mx = fmaxf(mx, __shfl_xor(mx, 16)); mx = fmaxf(mx, __shfl_xor(mx, 32));
  float sum = 0.f;
#pragma unroll
  for (int ti = 0; ti < 16; ++ti)
#pragma unroll
    for (int j = 0; j < 4; ++j) { const float e = s[ti][j] > -1e29f ? __expf(s[ti][j] - mx) : 0.f; s[ti][j] = e; sum += e; }
  sum += __shfl_xor(sum, 16); sum += __shfl_xor(sum, 32);
  const float inv = 1.f / sum;
  f32x4 o[4];
#pragma unroll
  for (int dt = 0; dt < 4; ++dt) o[dt] = (f32x4){0.f, 0.f, 0.f, 0.f};
#pragma unroll
  for (int a = 0; a < 8; ++a) { const bf16x8 pf = pack8(s[2 * a], s[2 * a + 1]);
#pragma unroll
    for (int dt = 0; dt < 4; ++dt) { const bf16_t* vp = VTN + (size_t)(dt * 16 + fr) * SEQ + (kr0 + a) * 64 + kc0 + fq * 4;
      o[dt] = mfma32(cat4(ld4(vp), ld4(vp + 16)), pf, o[dt]); } }
#pragma unroll
  for (int dt = 0; dt < 4; ++dt) *(bf16x4*)(U + qrow * LDU + C_YNA + hd * 64 + dt * 16 + fq * 4) = pack4(o[dt] * inv);
}

DEVI void phase_finalize(const Params& p, int l) {
  TIDL;
  WSP;
  const int wid = tid_ >> 6, lane = tid_ & 63;
  bf16_t* U = (bf16_t*)(ws_ + O_U);
  const _Float16* HL = (const _Float16*)(ws_ + O_HL); const _Float16* PP = (const _Float16*)(ws_ + O_PP); const float* CIN = (const float*)(ws_ + O_CIN);
  const float* hgn = p.in[8] + l * 512; const float* ssn = p.in[20] + l * 1024;
  for (int row = blockIdx.x * 8 + wid; row < NT; row += gridDim.x * 8) {
    bf16_t* ur = U + (size_t)row * LDU; const int b = row >> 12, tile = (row & 4095) >> 6;
    {
      const int c = lane * 8; const bf16x8 of = ld8(ur + C_OF + c), ob = ld8(ur + C_OB + c), gg = ld8(ur + C_HGG + c);
      float o[8], ss = 0.f;
#pragma unroll
      for (int i = 0; i < 8; ++i) { o[i] = bf2f((bf16_t)of[i]) + bf2f((bf16_t)ob[i]); ss += o[i] * o[i]; }
      ss += __shfl_xor(ss, 1); ss += __shfl_xor(ss, 2); ss += __shfl_xor(ss, 4); ss += __shfl_xor(ss, 8);
      const float r = rsqrtf(ss * (1.f / 128.f) + EPS); float y[8];
#pragma unroll
      for (int i = 0; i < 8; ++i) y[i] = o[i] * r * hgn[c + i] * siluf_(bf2f((bf16_t)gg[i]));
      *(u32x4*)(ur + C_YHG + c) = (u32x4){cvt_pk_bf16(y[0], y[1]), cvt_pk_bf16(y[2], y[3]), cvt_pk_bf16(y[4], y[5]), cvt_pk_bf16(y[6], y[7])}; }
    {
      const int c = lane * 8; const bf16x8 gg = ld8(ur + C_LRG + c); float y[8];
#pragma unroll
      for (int i = 0; i < 8; ++i) { float hsum = 0.f;
#pragma unroll
        for (int dir = 0; dir < 2; ++dir) { const size_t o = ((size_t)dir * NT + row) * 512 + c + i;
          hsum += (float)HL[o] + (float)PP[o] * CIN[(((size_t)dir * NB + b) * 64 + tile) * 512 + c + i]; }
        y[i] = hsum * gelu_tanh(bf2f((bf16_t)gg[i])); }
      *(u32x4*)(ur + C_YLR + c) = (u32x4){cvt_pk_bf16(y[0], y[1]), cvt_pk_bf16(y[2], y[3]), cvt_pk_bf16(y[4], y[5]), cvt_pk_bf16(y[6], y[7])}; }
    {
      const int c = lane * 16; float y[16], ss = 0.f;
#pragma unroll
      for (int hf = 0; hf < 2; ++hf) { const bf16x8 yf = ld8(ur + C_YSF + c + hf * 8), yb = ld8(ur + C_YSB + c + hf * 8), zz = ld8(ur + C_SSZ + c + hf * 8);
#pragma unroll
        for (int i = 0; i < 8; ++i) { const float v = (bf2f((bf16_t)yf[i]) + bf2f((bf16_t)yb[i])) * siluf_(bf2f((bf16_t)zz[i])); y[hf * 8 + i] = v; ss += v * v; } }
      ss = wave_sum(ss); const float r = rsqrtf(ss * (1.f / 1024.f) + EPS);
#pragma unroll
      for (int hf = 0; hf < 2; ++hf) { float t[8];
#pragma unroll
        for (int i = 0; i < 8; ++i) t[i] = y[hf * 8 + i] * r * ssn[c + hf * 8 + i];
        *(u32x4*)(ur + C_YSF + c + hf * 8) = (u32x4){cvt_pk_bf16(t[0], t[1]), cvt_pk_bf16(t[2], t[3]), cvt_pk_bf16(t[4], t[5]), cvt_pk_bf16(t[6], t[7])}; } }
  }
}

__global__ void __launch_bounds__(512) mk(Params p) {
  cg::grid_group grid = cg::this_grid();
  extern __shared__ __attribute__((aligned(16))) char smem[];
  LAS char* shm = (LAS char*)smem;
  __shared__ int s_item;
  unsigned* bar = (unsigned*)(p.ws + O_BAR); unsigned epoch = 0;
  bf16_t* U = (bf16_t*)(p.ws + O_U); bf16_t* H = (bf16_t*)(p.ws + O_H); bf16_t* W = (bf16_t*)(p.ws + O_W);
  float* MF = (float*)(p.ws + O_MF32); bf16_t* HID = (bf16_t*)(p.ws + O_HID);
  const float* mod = (const float*)(p.ws + O_MOD);
  float* X = p.X;

#ifndef NO_MOD
  phase_mod(p, smem);
#endif
#ifndef NO_WCONV
  phase_wconv(p, 0, smem);
#endif
  grid.sync();

  for (int l = 0; l < NL; ++l) {
    const float* modl = mod + (size_t)l * 4 * 6144;
#ifndef NO_WCONV
    if (l > 0) phase_wconv(p, l, smem);
#endif
#ifndef NO_NORM
    phase_norm(l == 0 ? p.in[0] : X, l == 0 ? X : nullptr, p.in[4] + l * DM, modl, 0, 1024, H);
#endif
    gsync(bar, epoch);
    for (int u = blockIdx.x; u < 64 * 49; u += gridDim.x) { int pm, pn; tile_of(u, 64, 49, pm, pn); const int brow = pm * 256, bcol = pn * 256;
      f32x4 acc[2][2][4][2];
#ifndef NO_GEMM1
      gemm_tile(H, DM, W + W_IN, DM, DM, brow, bcol, acc, shm);
#endif

      EPI_LOOP( *(bf16x4*)(U + (size_t)row * LDU + col) = pack4(v); ) }
    gsync(bar, epoch);
#ifndef NO_HGPRE
    phase_hg_pre(p, l);
#endif
#ifndef NO_TOK64
    for (int it = blockIdx.x; it < 256; it += gridDim.x) pre_tok64(p, l, it, smem);
#endif
    gsync(bar, epoch);
    { const int nb = gridDim.x;
      for (int it = blockIdx.x; it < 128 + 32 + 8; it += nb) {
        if (it < 128) {
#ifndef NO_SSD
          ssd_scan_item(p, l, it, smem);
#endif
        } else if (it < 160) {
#ifndef NO_HGSCAN
          hg_scan_item(p, it - 128);
#endif
        } else lru_carry_item(p, it - 160); }
      unsigned* q = bar + 16 + l;
      for (;;) { __syncthreads(); if (threadIdx.x == 0) s_item = (int)atomicAdd(q, 1u); __syncthreads(); const int it = s_item; if (it >= 1024) break;
#ifndef NO_NA
        na_item(p, l, it);
#endif
      } }
    gsync(bar, epoch);
#ifndef NO_FIN
    phase_finalize(p, l);
#endif
    gsync(bar, epoch);
    for (int u = blockIdx.x; u < 64 * 4; u += gridDim.x) { int pm, pn; tile_of(u, 64, 4, pm, pn); const int brow = pm * 256, bcol = pn * 256;
#pragma nounroll
      for (int seg = 0; seg < 4; ++seg) {
        const int acol = seg == 0 ? C_YHG : (seg == 1 ? C_YNA : (seg == 2 ? C_YLR : C_YSF));
        const bf16_t* wb = W + (seg == 0 ? W_BRHG : (seg == 1 ? W_BRNA : (seg == 2 ? W_BRLR : W_BRSS))); const int K = seg == 3 ? 1024 : 512;
        f32x4 acc[2][2][4][2];
#ifndef NO_GEMM2
        gemm_tile(U + acol, LDU, wb, K, K, brow, bcol, acc, shm);
#endif
        EPI_LOOP( const bf16x4 gz = ld4(U + (size_t)row * LDU + C_MRG + seg * 1024 + col); f32x4 r;
          for (int j = 0; j < 4; ++j) r[j] = v[j] * sigmoidf_(bf2f((bf16_t)gz[j]));
          float* mp = MF + (size_t)row * DM + col;
          if (seg > 0) r += *(f32x4*)mp;
          if (seg < 3) *(f32x4*)mp = r; else *(bf16x4*)(H + (size_t)row * DM + col) = pack4(r); ) } }
    gsync(bar, epoch);
    for (int u = blockIdx.x; u < 64 * 4; u += gridDim.x) { int pm, pn; tile_of(u, 64, 4, pm, pn); const int brow = pm * 256, bcol = pn * 256;
      f32x4 acc[2][2][4][2];
#ifndef NO_GEMM3
      gemm_tile(H, DM, W + W_OUT, DM, DM, brow, bcol, acc, shm);
#endif

      EPI_LOOP( const f32x4 gt = *(const f32x4*)(modl + (row >> 12) * 6144 + 2048 + col); float* xp = X + (size_t)row * DM + col;
        *(f32x4*)xp = *(f32x4*)xp + gt * v; ) }
    gsync(bar, epoch);
#ifndef NO_NORM
    phase_norm(X, nullptr, p.in[5] + l * DM, modl, 3072, 4096, H);
#endif
    gsync(bar, epoch);
    for (int u = blockIdx.x; u < 64 * 16; u += gridDim.x) { int pm, pn; tile_of(u, 64, 16, pm, pn); const int brow = pm * 256, bcol = pn * 256;
      f32x4 acc[2][2][4][2];
#ifndef NO_GEMM4
      gemm_tile(H, DM, W + W_FF1, DM, DM, brow, bcol, acc, shm);
#endif

      EPI_LOOP( f32x4 r; for (int j = 0; j < 4; ++j) { const float t = fmaxf(v[j], 0.f); r[j] = t * t; }
        *(bf16x4*)(HID + (size_t)row * DFF + col) = pack4(r); ) }
    gsync(bar, epoch);
    for (int u = blockIdx.x; u < 64 * 4; u += gridDim.x) { int pm, pn; tile_of(u, 64, 4, pm, pn); const int brow = pm * 256, bcol = pn * 256;
      f32x4 acc[2][2][4][2];
#ifndef NO_GEMM5
      gemm_tile(HID, DFF, W + W_FF2, DFF, DFF, brow, bcol, acc, shm);
#endif

      EPI_LOOP( const f32x4 gt = *(const f32x4*)(modl + (row >> 12) * 6144 + 5120 + col); float* xp = X + (size_t)row * DM + col;
        *(f32x4*)xp = *(f32x4*)xp + gt * v; ) }
    gsync(bar, epoch);
  }
#ifndef NO_NORM
  phase_final_norm(X, p.in[28]);
#endif
}

extern "C" void kernel_launch(void* const* d_in, const int* in_sizes, int n_in, void* d_out, int out_size,
                              void* d_ws, size_t ws_size, hipStream_t stream) {
  constexpr size_t kDynLds = 136 * 1024;
  static int grid_blocks = 0;
  if (!grid_blocks) {
    int dev = 0, cus = 0, per_cu = 0;
    (void)hipGetDevice(&dev);
    (void)hipDeviceGetAttribute(&cus, hipDeviceAttributeMultiprocessorCount, dev);
    (void)hipFuncSetAttribute((const void*)mk, hipFuncAttributeMaxDynamicSharedMemorySize, (int)kDynLds);
    (void)hipOccupancyMaxActiveBlocksPerMultiprocessor(&per_cu, mk, 512, kDynLds);
    if (per_cu < 1) per_cu = 1;
    grid_blocks = cus;
  }
  Params p{};
  for (int i = 0; i < 29; ++i) p.in[i] = (const float*)d_in[i];
  p.X = (float*)d_out; p.ws = (char*)d_ws;
  (void)hipMemsetAsync(d_ws, 0, 4096, stream);
  void* args[] = {&p};
  hipError_t e = hipLaunchCooperativeKernel((void*)mk, dim3(grid_blocks), dim3(512), args, kDynLds, stream);
  if (e != hipSuccess) fprintf(stderr, "cooperative launch failed: %s (grid %d)\n", hipGetErrorString(e), grid_blocks);
}
```

```cpp
#include <hip/hip_runtime.h>
#include <hip/hip_cooperative_groups.h>
#include <cstdio>
#include <cstdint>
namespace cg = cooperative_groups;
#ifndef DIAG
#define DIAG 0
#endif
#ifndef DUP
#define DUP 0
#endif
#define REP(id) _Pragma("nounroll") for (int rep_ = 0; rep_ < 1 + ((DUP >> (id)) & 1); ++rep_)
#ifndef TX
#define TX 4
#endif
#ifndef TY
#define TY 12
#endif

#define DEVI __device__ __forceinline__
#define LAS __attribute__((address_space(3)))
#define LAUNDER(x) asm volatile("" : "+s"(x))
#define WSP char* ws_ = p.ws; LAUNDER(ws_)
#define TIDL int tid_ = threadIdx.x; asm volatile("" : "+v"(tid_))
typedef unsigned short bf16_t;
typedef short bf16x8 __attribute__((ext_vector_type(8)));
typedef short bf16x4 __attribute__((ext_vector_type(4)));
typedef float f32x4 __attribute__((ext_vector_type(4)));
typedef unsigned u32x4 __attribute__((ext_vector_type(4)));
typedef unsigned u32x2 __attribute__((ext_vector_type(2)));

constexpr int DM = 1024, NB = 4, SEQ = 4096, NT = NB * SEQ, NL = 4, NIN = 12320, LDU = 12544, DFF = 4096;
constexpr float EPS = 1e-6f;
constexpr int C_HGQ = 0, C_HGZF = 512, C_HGZB = 1024, C_HGI = 1536, C_HGG = 2048, C_NAQ = 2560, C_NAK = 3072, C_NAV = 3584,
              C_LRX = 4096, C_LRG = 4608, C_SSZ = 5120, C_SSX = 6144, C_SSB = 7168, C_SSC = 7680, C_SSDT = 8192, C_MRG = 8224;
constexpr int C_YHG = 0, C_OF = 512, C_OB = 1024, C_YNA = 1536, C_YLR = 4096, C_YSF = 6144, C_YSB = 7168, C_YSS = 3072, C_YD0 = 0, C_YD1 = 4096;

constexpr size_t MiB = 1048576;
constexpr size_t O_BAR = 0;
constexpr size_t O_MOD = 16384;
constexpr size_t O_LBV = O_MOD + 4 * 4 * 6144 * 4;
constexpr size_t O_W = 1 * MiB;
constexpr size_t W_IN = 0, W_BRHG = W_IN + (size_t)LDU * 1024, W_BRNA = W_BRHG + 1024 * 1024, W_BRLR = W_BRNA + 1024 * 1024,
                 W_BRSS = W_BRLR + 1024 * 1024, W_OUT = W_BRSS + 1024 * 1024, W_FF1 = W_OUT + 1024 * 1024, W_FF2 = W_FF1 + 4096 * 1024,
                 W_LRG = W_FF2 + 4096 * 1024, W_END = W_LRG + 32 * 4096;
constexpr size_t O_U = O_W + 51 * MiB;
constexpr size_t O_H = O_U + (size_t)NT * LDU * 2;
constexpr size_t O_QT = O_H + 32 * MiB;
constexpr size_t O_KC = O_QT + 32 * MiB;
constexpr size_t O_KT = O_KC + 32 * MiB;
constexpr size_t O_VT = O_KT + 32 * MiB;
constexpr size_t O_DEC = O_VT + 16 * MiB;
constexpr size_t O_VTN = O_DEC + 4 * MiB;
constexpr size_t O_HL = O_VTN + 16 * MiB;
constexpr size_t O_PP = O_HL + 32 * MiB;
constexpr size_t O_CP = O_PP + 32 * MiB;
constexpr size_t O_CH = O_CP + 1 * MiB;
constexpr size_t O_CIN = O_CH + 1 * MiB;
constexpr size_t O_XST = O_CIN + 1 * MiB;
constexpr size_t O_BM = O_XST + 32 * MiB;
constexpr size_t O_CM = O_BM + 16 * MiB;
constexpr size_t O_BT = O_CM + 16 * MiB;
constexpr size_t O_DT = O_BT + 16 * MiB;
constexpr size_t O_AA = O_DT + 2 * MiB;
constexpr size_t O_END = O_AA + 2 * MiB;
constexpr size_t O_MF32 = O_QT;
constexpr size_t O_HID = O_U;
static_assert(W_END * 2 <= 51 * MiB, "weights region");
static_assert(O_END <= 770 * MiB, "workspace");

struct Params {
  const float* in[29];
  float* X;
  char* ws;
};

DEVI float bf2f(bf16_t h) { return __uint_as_float((unsigned)h << 16); }
typedef float f32x2_ __attribute__((ext_vector_type(2)));
typedef __bf16 bf16v2_ __attribute__((ext_vector_type(2)));
DEVI unsigned cvt_pk_bf16(float lo, float hi) { const f32x2_ v = {lo, hi}; const bf16v2_ r = __builtin_convertvector(v, bf16v2_); return __builtin_bit_cast(unsigned, r); }
DEVI bf16_t f2bf(float f) { return (bf16_t)(cvt_pk_bf16(f, 0.f) & 0xffffu); }
DEVI float sigmoidf_(float x) { return __builtin_amdgcn_rcpf(1.f + __expf(-x)); }
DEVI float siluf_(float x) { return x * __builtin_amdgcn_rcpf(1.f + __expf(-x)); }
DEVI float softplusf_(float x) { return x > 20.f ? x : log1pf(__expf(x)); }
DEVI float gelu_tanh(float x) { float u = 0.7978845608028654f * (x + 0.044715f * x * x * x); float e = __expf(2.f * u); float th = 1.f - 2.f * __builtin_amdgcn_rcpf(e + 1.f); return 0.5f * x * (1.f + th); }
DEVI float wave_sum(float v) { for (int o = 32; o > 0; o >>= 1) v += __shfl_xor(v, o); return v; }
DEVI bf16x8 cat4(bf16x4 a, bf16x4 b) { return __builtin_shufflevector(a, b, 0, 1, 2, 3, 4, 5, 6, 7); }
DEVI bf16x4 pack4(f32x4 v) { u32x2 r; r.x = cvt_pk_bf16(v[0], v[1]); r.y = cvt_pk_bf16(v[2], v[3]); return __builtin_bit_cast(bf16x4, r); }
DEVI bf16x8 pack8(f32x4 a, f32x4 b) { u32x4 r; r.x = cvt_pk_bf16(a[0], a[1]); r.y = cvt_pk_bf16(a[2], a[3]); r.z = cvt_pk_bf16(b[0], b[1]); r.w = cvt_pk_bf16(b[2], b[3]); return __builtin_bit_cast(bf16x8, r); }
DEVI f32x4 mfma32(bf16x8 a, bf16x8 b, f32x4 c) { return __builtin_amdgcn_mfma_f32_16x16x32_bf16(a, b, c, 0, 0, 0); }
DEVI f32x4 mfma16(bf16x4 a, bf16x4 b, f32x4 c) { return __builtin_amdgcn_mfma_f32_16x16x16bf16_1k(a, b, c, 0, 0, 0); }
DEVI bf16x8 ld8(const bf16_t* p) { return *(const bf16x8*)p; }
DEVI bf16x4 ld4(const bf16_t* p) { return *(const bf16x4*)p; }

#define XB_TMO      128
#define XB_XCNT(j)  (256  + 64 * (j))
#define XB_XSUB(j)  (1280 + 64 * (j))
#define XB_XGEN(j)  (2304 + 64 * (j))
#define XB_TOP      3328
#define XB_TOPGEN   3392
#define XB_SPIN_CAP (1u << 22)
DEVI unsigned xb_ld(unsigned* p) { return __hip_atomic_load(p, __ATOMIC_RELAXED, __HIP_MEMORY_SCOPE_AGENT); }
DEVI unsigned xb_add(unsigned* p, unsigned v) { return __hip_atomic_fetch_add(p, v, __ATOMIC_RELAXED, __HIP_MEMORY_SCOPE_AGENT); }
DEVI unsigned xb_xcc_id() { return (unsigned)__builtin_amdgcn_s_getreg((3 << 11) | 20) & 0xFu; }
#define XB_SPIN(cond, bar) do { unsigned _sp = 0; while (cond) { __builtin_amdgcn_s_sleep(1); \
    if ((++_sp & 255u) == 0u) { if (xb_ld(&(bar)[XB_TMO])) break; if (_sp > XB_SPIN_CAP) { atomicAdd(&(bar)[XB_TMO], 1u); break; } } } } while (0)
struct XcdBarrier { unsigned* bar; unsigned x; volatile LAS unsigned* st; };
DEVI XcdBarrier xcd_barrier_post(unsigned* bar, volatile LAS unsigned* st) {
  XcdBarrier b; b.bar = bar; b.x = xb_xcc_id(); b.st = st;
  if (threadIdx.x == 0) (void)xb_add(&bar[XB_XCNT(b.x)], 1u);
  return b;
}
DEVI void xcd_barrier_complete(unsigned* bar, unsigned x, unsigned& nloc, unsigned& nx) {
  const unsigned G = gridDim.x; unsigned sum, cnt, mine, sp = 0u;
  for (;;) { sum = 0u; cnt = 0u; mine = 0u;
#pragma unroll
    for (unsigned j = 0; j < 16; ++j) { const unsigned c = xb_ld(&bar[XB_XCNT(j)]); sum += c; cnt += (c > 0u) ? 1u : 0u; mine = (j == x) ? c : mine; }
    if (sum == G) break;
    __builtin_amdgcn_s_sleep(1);
    if ((++sp & 255u) == 0u) { if (xb_ld(&bar[XB_TMO])) break; if (sp > XB_SPIN_CAP) { atomicAdd(&bar[XB_TMO], 1u); break; } } }
  nloc = mine > 0u ? mine : 1u; nx = cnt > 0u ? cnt : 1u;
}
DEVI void xcd_barrier(const XcdBarrier& b) {
  asm volatile("s_waitcnt vmcnt(0)" ::: "memory");
  __syncthreads();
  if (threadIdx.x == 0) {
    unsigned* bar = b.bar;
    __builtin_amdgcn_s_waitcnt(0);
    unsigned nloc = b.st[0], nx = b.st[1];
    if (nloc == 0u) { xcd_barrier_complete(bar, b.x, nloc, nx); b.st[0] = nloc; b.st[1] = nx; }
    const unsigned old = xb_add(&bar[XB_XSUB(b.x)], 1u);
    const unsigned gen = old / nloc;
    if (old + 1u == (gen + 1u) * nloc) {
      __builtin_amdgcn_fence(__ATOMIC_RELEASE, "agent");
      asm volatile("s_waitcnt vmcnt(0)" ::: "memory");
      const unsigned og = xb_add(&bar[XB_TOP], 1u);
      const unsigned tg = og / nx;
      if (og + 1u == (tg + 1u) * nx) xb_add(&bar[XB_TOPGEN], 1u);
      else XB_SPIN(xb_ld(&bar[XB_TOPGEN]) == tg, bar);
      __builtin_amdgcn_fence(__ATOMIC_ACQUIRE, "agent");
      xb_add(&bar[XB_XGEN(b.x)], 1u);
      asm volatile("s_waitcnt vmcnt(0)" ::: "memory");
    } else {
      XB_SPIN(xb_ld(&bar[XB_XGEN(b.x)]) == gen, bar);
      __builtin_amdgcn_fence(__ATOMIC_ACQUIRE, "agent");
      asm volatile("s_waitcnt vmcnt(0)" ::: "memory");
    }
  }
  __syncthreads();
}
#define gsync(bar_, epoch_) xcd_barrier(xb)

constexpr int HTB = 128 * 64 * 2;
DEVI int lds_byte(int r, int c) { int st = (r >> 4) * 2 + (c >> 5), rr = r & 15, cc = c & 31, ob = rr * 64 + cc * 2; return st * 1024 + (ob ^ (((ob >> 9) & 1) << 5)); }
DEVI void stage_rc(int b, int& R, int& C) { int st = b / 1024, sb = b % 1024, swz = sb ^ (((sb >> 9) & 1) << 5); R = (st >> 1) * 16 + swz / 64; C = (st & 1) * 32 + (swz % 64) / 2; }

#define SA(b, h) (((b) * 2 + (h)) * HTB)
#define SB(b, h) ((4 + (b) * 2 + (h)) * HTB)
#define STAGE(bufoff, gbase, voff) do { _Pragma("unroll") for (int _i = 0; _i < 2; ++_i) \
    __builtin_amdgcn_global_load_lds((const unsigned*)((const char*)(gbase) + (voff)[_i]), (LAS unsigned*)(shm + (bufoff) + ldsw + _i * 8192), 16, 0, 0); } while (0)
#define LDA(dst, b, h) do { _Pragma("unroll") for (int m = 0; m < 4; ++m) _Pragma("unroll") for (int k = 0; k < 2; ++k) dst[m][k] = *(const LAS bf16x8*)(shm + SA(b, h) + aoff + m * 2048 + k * 1024); } while (0)
#define LDB(dst, b, h) do { _Pragma("unroll") for (int n = 0; n < 2; ++n) _Pragma("unroll") for (int k = 0; k < 2; ++k) dst[n][k] = *(const LAS bf16x8*)(shm + SB(b, h) + boff + n * 2048 + k * 1024); } while (0)
#define MMA(ai, bj, At_, Bt_) do { __builtin_amdgcn_s_setprio(1); \
    _Pragma("unroll") for (int m = 0; m < 4; ++m) _Pragma("unroll") for (int n = 0; n < 2; ++n) _Pragma("unroll") for (int k = 0; k < 2; ++k) \
      acc[ai][bj][m][n] = __builtin_amdgcn_mfma_f32_16x16x32_bf16(Bt_[n][k], At_[m][k], acc[ai][bj][m][n], 0, 0, 0); \
    __builtin_amdgcn_s_setprio(0); } while (0)
#define WAIT_V(n) asm volatile("s_waitcnt vmcnt(" #n ")" ::: "memory")
#define WAIT_L(n) asm volatile("s_waitcnt lgkmcnt(" #n ")" ::: "memory")
#define BAR __builtin_amdgcn_s_barrier()
#define SCHED __builtin_amdgcn_sched_barrier(0)

DEVI void gemm_tile(const bf16_t* A, int lda, const bf16_t* Bt, int ldb, int K, int brow, int bcol, f32x4 (&acc)[2][2][4][2], LAS char* shm) {
  TIDL; const int tid = tid_, wid = __builtin_amdgcn_readfirstlane(tid >> 6), lane = tid & 63, wr = wid >> 2, wc = wid & 3, fr = lane & 15, fq = lane >> 4;
#pragma unroll
  for (int a = 0; a < 2; ++a)
#pragma unroll
    for (int b = 0; b < 2; ++b)
#pragma unroll
      for (int m = 0; m < 4; ++m)
#pragma unroll
        for (int n = 0; n < 2; ++n) acc[a][b][m][n] = (f32x4){0.f, 0.f, 0.f, 0.f};
  unsigned voffA[2], voffB[2];
#pragma unroll
  for (int i = 0; i < 2; ++i) { int R, C; stage_rc(tid * 16 + i * 8192, R, C); voffA[i] = (unsigned)(R * lda + C) * 2u; voffB[i] = (unsigned)(R * ldb + C) * 2u; }
  const size_t kstep = 128, hstepA = (size_t)128 * lda * 2, hstepB = (size_t)128 * ldb * 2;
  const unsigned ldsw = (unsigned)wid * 1024u;
  const int aoff = lds_byte(wr * 64 + fr, fq * 8), boff = lds_byte(wc * 32 + fr, fq * 8);
  const char* cA = (const char*)A + (size_t)brow * lda * 2; const char* cB = (const char*)Bt + (size_t)bcol * ldb * 2;
  bf16x8 At[4][2], B0[2][2], B1[2][2];
  const int nt = K / 64;
  STAGE(SB(0, 0), cB, voffB); STAGE(SA(0, 0), cA, voffA); STAGE(SB(0, 1), cB + hstepB, voffB); STAGE(SA(0, 1), cA + hstepA, voffA);
  if (wr == 1) BAR;
  WAIT_V(4); BAR;
  STAGE(SB(1, 0), cB + kstep, voffB); STAGE(SA(1, 0), cA + kstep, voffA); STAGE(SB(1, 1), cB + hstepB + kstep, voffB);
  WAIT_V(6); BAR;
  for (int t = 0; t < nt - 2; t += 2) {
    const char* a1 = cA + (size_t)(t + 1) * kstep; const char* a2 = cA + (size_t)(t + 2) * kstep; const char* b2 = cB + (size_t)(t + 2) * kstep;
    const char* a3 = a2 + kstep; const char* b3 = b2 + kstep;
    LDB(B0, 0, 0); SCHED; LDA(At, 0, 0); STAGE(SA(1, 1), a1 + hstepA, voffA);
    WAIT_L(8); BAR; WAIT_L(0); MMA(0, 0, At, B0); BAR; SCHED;
    LDB(B1, 0, 1); STAGE(SB(0, 0), b2, voffB);
    BAR; WAIT_L(0); MMA(0, 1, At, B1); BAR;
    LDA(At, 0, 1); STAGE(SA(0, 0), a2, voffA);
    BAR; WAIT_L(0); MMA(1, 0, At, B0); BAR; SCHED;
    STAGE(SB(0, 1), b2 + hstepB, voffB);
    WAIT_V(6); BAR; MMA(1, 1, At, B1); BAR;
    LDB(B0, 1, 0); SCHED; LDA(At, 1, 0); STAGE(SA(0, 1), a2 + hstepA, voffA);
    WAIT_L(8); BAR; WAIT_L(0); MMA(0, 0, At, B0); BAR; SCHED;
    LDB(B1, 1, 1); STAGE(SB(1, 0), b3, voffB);
    BAR; WAIT_L(0); MMA(0, 1, At, B1); BAR;
    LDA(At, 1, 1); STAGE(SA(1, 0), a3, voffA);
    BAR; WAIT_L(0); MMA(1, 0, At, B0); BAR; SCHED;
    STAGE(SB(1, 1), b3 + hstepB, voffB);
    WAIT_V(6); BAR; MMA(1, 1, At, B1); BAR;
  }
  { const char* a1 = cA + (size_t)(nt - 1) * kstep;
    LDB(B0, 0, 0); LDA(At, 0, 0); STAGE(SA(1, 1), a1 + hstepA, voffA);
    BAR; WAIT_L(0); MMA(0, 0, At, B0); BAR;
    LDB(B1, 0, 1); BAR; WAIT_L(0); MMA(0, 1, At, B1); BAR;
    LDA(At, 0, 1); WAIT_V(4); BAR; WAIT_L(0); MMA(1, 0, At, B0); MMA(1, 1, At, B1); BAR; }
  { LDB(B0, 1, 0); LDA(At, 1, 0); WAIT_V(2); BAR; WAIT_L(0); MMA(0, 0, At, B0); BAR;
    LDB(B1, 1, 1); WAIT_V(0); BAR; WAIT_L(0); MMA(0, 1, At, B1); BAR;
    LDA(At, 1, 1); BAR; WAIT_L(0); MMA(1, 0, At, B0); MMA(1, 1, At, B1); BAR; }
  if (wr == 0) BAR;
}

struct GUnit { const char* cA; const char* cB; int nt, brow, bcol, aux, keep; };
template <class UF, class EF>
DEVI void gemm_stream(LAS char* shm, int lda, int ldb, UF unit, EF epi) {
  TIDL; const int tid = tid_, wid = __builtin_amdgcn_readfirstlane(tid >> 6), lane = tid & 63, wr = wid >> 2, wc = wid & 3, fr = lane & 15, fq = lane >> 4;
  GUnit cur, nxt; int ui = 0;
  if (!unit(0, cur)) return;
  f32x4 acc[2][2][4][2];
#pragma unroll
  for (int a = 0; a < 2; ++a)
#pragma unroll
    for (int b = 0; b < 2; ++b)
#pragma unroll
      for (int m = 0; m < 4; ++m)
#pragma unroll
        for (int n = 0; n < 2; ++n) acc[a][b][m][n] = (f32x4){0.f, 0.f, 0.f, 0.f};
  unsigned voffA[2], voffB[2];
#pragma unroll
  for (int i = 0; i < 2; ++i) { int R, C; stage_rc(tid * 16 + i * 8192, R, C); voffA[i] = (unsigned)(R * lda + C) * 2u; voffB[i] = (unsigned)(R * ldb + C) * 2u; }
  const size_t kstep = 128, hstepA = (size_t)128 * lda * 2, hstepB = (size_t)128 * ldb * 2;
  const unsigned ldsw = (unsigned)wid * 1024u;
  const int aoff = lds_byte(wr * 64 + fr, fq * 8), boff = lds_byte(wc * 32 + fr, fq * 8);
  bf16x8 At[4][2], B0[2][2], B1[2][2];
  { const char* cA = cur.cA; const char* cB = cur.cB;
    STAGE(SB(0, 0), cB, voffB); STAGE(SA(0, 0), cA, voffA); STAGE(SB(0, 1), cB + hstepB, voffB); STAGE(SA(0, 1), cA + hstepA, voffA);
    if (wr == 1) BAR;
    WAIT_V(4); BAR;
    STAGE(SB(1, 0), cB + kstep, voffB); STAGE(SA(1, 0), cA + kstep, voffA); STAGE(SB(1, 1), cB + hstepB + kstep, voffB);
    WAIT_V(6); BAR; }
  for (;;) {
    const bool has_next = unit(ui + 1, nxt);
    const char* cA = cur.cA; const char* cB = cur.cB;
    const char* nA = has_next ? nxt.cA : cA; const char* nB = has_next ? nxt.cB : cB;
    const int nt = cur.nt;
#pragma nounroll
    for (int t = 0; t < nt; t += 2) {
      const bool last = (t == nt - 2);
      const char* a1 = cA + (size_t)(t + 1) * kstep;
      const char* a2 = last ? nA : cA + (size_t)(t + 2) * kstep; const char* b2 = last ? nB : cB + (size_t)(t + 2) * kstep;
      const char* a3 = a2 + kstep; const char* b3 = b2 + kstep;
      LDB(B0, 0, 0); SCHED; LDA(At, 0, 0); STAGE(SA(1, 1), a1 + hstepA, voffA);
      WAIT_L(8); BAR; WAIT_L(0); MMA(0, 0, At, B0); BAR; SCHED;
      LDB(B1, 0, 1); STAGE(SB(0, 0), b2, voffB);
      BAR; WAIT_L(0); MMA(0, 1, At, B1); BAR;
      LDA(At, 0, 1); STAGE(SA(0, 0), a2, voffA);
      BAR; WAIT_L(0); MMA(1, 0, At, B0); BAR; SCHED;
      STAGE(SB(0, 1), b2 + hstepB, voffB);
      WAIT_V(6); BAR; MMA(1, 1, At, B1); BAR;
      LDB(B0, 1, 0); SCHED; LDA(At, 1, 0); STAGE(SA(0, 1), a2 + hstepA, voffA);
      WAIT_L(8); BAR; WAIT_L(0); MMA(0, 0, At, B0); BAR; SCHED;
      LDB(B1, 1, 1); STAGE(SB(1, 0), b3, voffB);
      BAR; WAIT_L(0); MMA(0, 1, At, B1); BAR;
      LDA(At, 1, 1); STAGE(SA(1, 0), a3, voffA);
      BAR; WAIT_L(0); MMA(1, 0, At, B0); BAR; SCHED;
      STAGE(SB(1, 1), b3 + hstepB, voffB);
      WAIT_V(6); BAR; MMA(1, 1, At, B1); BAR;
    }
    epi(cur, acc);
    if (!has_next) break;
    if (!cur.keep)
#pragma unroll
    for (int a = 0; a < 2; ++a)
#pragma unroll
      for (int b = 0; b < 2; ++b)
#pragma unroll
        for (int m = 0; m < 4; ++m)
#pragma unroll
          for (int n = 0; n < 2; ++n) acc[a][b][m][n] = (f32x4){0.f, 0.f, 0.f, 0.f};
    cur = nxt; ++ui;
  }
  WAIT_V(0);
  if (wr == 0) BAR;
  BAR;
}

DEVI void tile_of(int u, int nM, int nN, int& pm, int& pn) {
  const int nwg = nM * nN; int wgid = u;
  { const int q = nwg / 8, r = nwg % 8, xcd = wgid % 8, off = wgid / 8; wgid = (xcd < r ? xcd * (q + 1) : r * (q + 1) + (xcd - r) * q) + off; }
  const int nig = 8 * nN, gid = wgid / nig, fm = gid * 8, gsz = (nM - fm) < 8 ? (nM - fm) : 8;
  pm = fm + ((wgid % nig) % gsz); pn = (wgid % nig) / gsz;
}

template <int GM, class LF, class BF>
DEVI void epi_loop2(f32x4 (&acc)[2][2][4][2], int brow, int bcol, LF loadf, BF bodyf) {
  TIDL; const int wid = __builtin_amdgcn_readfirstlane(tid_ >> 6), lane = tid_ & 63, wr = wid >> 2, wc = wid & 3, fr = lane & 15, fq = lane >> 4;
#pragma unroll
  for (int ai = 0; ai < 2; ++ai)
#pragma unroll
    for (int mg = 0; mg < 4; mg += GM) {
      int rowb = brow + ai * 128 + wr * 64 + mg * 16 + fr; asm volatile("" : "+v"(rowb));
      f32x4 ld_[GM][4];
#pragma unroll
      for (int mm = 0; mm < GM; ++mm)
#pragma unroll
        for (int bj = 0; bj < 2; ++bj)
#pragma unroll
          for (int n = 0; n < 2; ++n) ld_[mm][bj * 2 + n] = loadf(rowb + mm * 16, bcol + bj * 128 + wc * 32 + n * 16 + fq * 4);
#pragma unroll
      for (int mm = 0; mm < GM; ++mm)
#pragma unroll
        for (int bj = 0; bj < 2; ++bj)
#pragma unroll
          for (int n = 0; n < 2; ++n) bodyf(rowb + mm * 16, bcol + bj * 128 + wc * 32 + n * 16 + fq * 4, acc[ai][bj][mg + mm][n], ld_[mm][bj * 2 + n]);
      asm volatile("" ::: "memory");
    }
}
#define EPI_LOOP(BODY) { TIDL; const int wid = __builtin_amdgcn_readfirstlane(tid_ >> 6), lane = tid_ & 63, wr = wid >> 2, wc = wid & 3, fr = lane & 15, fq = lane >> 4; \
  _Pragma("unroll") for (int ai = 0; ai < 2; ++ai) _Pragma("unroll") for (int m = 0; m < 4; ++m) { \
    int row = brow + ai * 128 + wr * 64 + m * 16 + fr; asm volatile("" : "+v"(row)); \
    _Pragma("unroll") for (int bj = 0; bj < 2; ++bj) _Pragma("unroll") for (int n = 0; n < 2; ++n) { \
      const int col = bcol + bj * 128 + wc * 32 + n * 16 + fq * 4; f32x4 v = acc[ai][bj][m][n]; BODY } asm volatile("" ::: "memory"); } }

DEVI void phase_mod(const Params& p, char* smem) {
  TIDL;
  WSP;
  float* cs = (float*)smem; float* red = cs + 4096;
  const float* c = p.in[1]; const float* w_ada = p.in[2]; const float* b_ada = p.in[3];
  float* mod = (float*)(ws_ + O_MOD);
  for (int i = tid_; i < 4096; i += 512) cs[i] = siluf_(c[i]);
  __syncthreads();
  const int col = tid_ & 63, kg = tid_ >> 6;
  for (int it = blockIdx.x; it < 4 * 96; it += gridDim.x) {
    const int l = it / 96, cb = it % 96, j = cb * 64 + col;
    const float* w = w_ada + (size_t)l * 1024 * 6144 + j;
    float a0 = 0, a1 = 0, a2 = 0, a3 = 0;
#pragma unroll 8
    for (int k = kg * 128; k < kg * 128 + 128; ++k) { const float wv = w[(size_t)k * 6144]; a0 += cs[k] * wv; a1 += cs[1024 + k] * wv; a2 += cs[2048 + k] * wv; a3 += cs[3072 + k] * wv; }
    red[(kg * 64 + col) * 4 + 0] = a0; red[(kg * 64 + col) * 4 + 1] = a1; red[(kg * 64 + col) * 4 + 2] = a2; red[(kg * 64 + col) * 4 + 3] = a3;
    __syncthreads();
    if (tid_ < 256) { const int c2 = tid_ & 63, b = tid_ >> 6; float s = 0;
      for (int g = 0; g < 8; ++g) s += red[(g * 64 + c2) * 4 + b];
      mod[(l * 4 + b) * 6144 + cb * 64 + c2] = s + b_ada[l * 6144 + cb * 64 + c2]; }
    __syncthreads();
  }
  if (blockIdx.x == gridDim.x - 1) {
    const float* hg_lb = p.in[7]; float* lbv = (float*)(ws_ + O_LBV);
    for (int i = tid_; i < 1024; i += 512) { const int dir = i >> 9, k = i & 511;
      float v[4], mx = -1e30f; for (int l = 0; l < 4; ++l) { v[l] = hg_lb[(dir * 4 + l) * 512 + k]; mx = fmaxf(mx, v[l]); }
      float s = 0; for (int l = 0; l < 4; ++l) { v[l] = __expf(v[l] - mx); s += v[l]; }
      float cum = 0; lbv[(dir * 4 + 0) * 512 + k] = 0.f;
      for (int l = 1; l < 4; ++l) { cum += v[l]; lbv[(dir * 4 + l) * 512 + k] = cum / s; } }
  }
}

DEVI void tconv_batch4(const float* src, int K, int N, bf16_t* dst, int ldd, int ntn, int i0, float* tiles) {
  TIDL; const int tid = tid_;
  f32x4 v[4][2];
  const int kr = tid >> 4, nc = (tid & 15) * 4;
#pragma unroll
  for (int q = 0; q < 4; ++q) { const int k0 = ((i0 + q) / ntn) * 64, n0 = ((i0 + q) % ntn) * 64;
#pragma unroll
    for (int i = 0; i < 2; ++i) { const int k = kr + i * 32; v[q][i] = (f32x4){0.f, 0.f, 0.f, 0.f};
      if (n0 + nc < N) v[q][i] = *(const f32x4*)(src + (size_t)(k0 + k) * N + n0 + nc); } }
#pragma unroll
  for (int q = 0; q < 4; ++q) { float* tile = tiles + q * 4160;
#pragma unroll
    for (int i = 0; i < 2; ++i) { const int k = kr + i * 32;
      tile[k * 65 + nc + 0] = v[q][i][0]; tile[k * 65 + nc + 1] = v[q][i][1]; tile[k * 65 + nc + 2] = v[q][i][2]; tile[k * 65 + nc + 3] = v[q][i][3]; } }
  __syncthreads();
#pragma unroll
  for (int q = 0; q < 4; ++q) { const int k0 = ((i0 + q) / ntn) * 64, n0 = ((i0 + q) % ntn) * 64; const float* tile = tiles + q * 4160;
    const int n = tid >> 3, k8 = (tid & 7) * 8; u32x4 w;
    w.x = cvt_pk_bf16(tile[(k8 + 0) * 65 + n], tile[(k8 + 1) * 65 + n]); w.y = cvt_pk_bf16(tile[(k8 + 2) * 65 + n], tile[(k8 + 3) * 65 + n]);
    w.z = cvt_pk_bf16(tile[(k8 + 4) * 65 + n], tile[(k8 + 5) * 65 + n]); w.w = cvt_pk_bf16(tile[(k8 + 6) * 65 + n], tile[(k8 + 7) * 65 + n]);
    *(u32x4*)(dst + (size_t)(n0 + n) * ldd + k0 + k8) = w; }
  __syncthreads();
}
DEVI void phase_wconv(const Params& p, int l, char* smem) {
  WSP;
  float* tile = (float*)smem; bf16_t* W = (bf16_t*)(ws_ + O_W);
  for (int g = blockIdx.x; g < 6112 / 4; g += gridDim.x) {
    int i = g * 4;
    if (i < 3136) { tconv_batch4(p.in[6] + (size_t)l * 1024 * NIN, 1024, NIN, W + W_IN, 1024, 196, i, tile); continue; } i -= 3136;
    if (i < 128) { tconv_batch4(p.in[21] + (size_t)l * 512 * 1024, 512, 1024, W + W_BRHG, 1024, 16, i, tile); continue; } i -= 128;
    if (i < 128) { tconv_batch4(p.in[22] + (size_t)l * 512 * 1024, 512, 1024, W + W_BRNA, 1024, 16, i, tile); continue; } i -= 128;
    if (i < 128) { tconv_batch4(p.in[23] + (size_t)l * 512 * 1024, 512, 1024, W + W_BRLR, 1024, 16, i, tile); continue; } i -= 128;
    if (i < 256) { tconv_batch4(p.in[24] + (size_t)l * 1024 * 1024, 1024, 1024, W + W_BRSS, 1024, 16, i, tile); continue; } i -= 256;
    if (i < 256) { tconv_batch4(p.in[25] + (size_t)l * 1024 * 1024, 1024, 1024, W + W_OUT, 1024, 16, i, tile); continue; } i -= 256;
    if (i < 1024) { tconv_batch4(p.in[26] + (size_t)l * 1024 * 4096, 1024, 4096, W + W_FF1, 1024, 64, i, tile); continue; } i -= 1024;
    if (i < 1024) { tconv_batch4(p.in[27] + (size_t)l * 4096 * 1024, 4096, 1024, W + W_FF2, 4096, 16, i, tile); continue; } i -= 1024;
    tconv_batch4(p.in[12] + (size_t)l * 32 * 4096, 64 * 32, 64, W + W_LRG, 2048, 1, i, tile);
  }
}

DEVI void phase_norm(const float* src, float* xcopy, const float* g, const float* mod, int shift_off, int scale_off, bf16_t* H) {
  TIDL;
  const int wid = tid_ >> 6, lane = tid_ & 63;
  const int stride = gridDim.x * 8;
  for (int row = blockIdx.x * 8 + wid; row < NT; row += 2 * stride) {
    const int row2 = row + stride;
    const bool has2 = row2 < NT;
    f32x4 v[2][4]; float ss[2] = {0.f, 0.f};
#pragma unroll
    for (int rr = 0; rr < 2; ++rr)
#pragma unroll
      for (int i = 0; i < 4; ++i) { v[rr][i] = (rr == 0 || has2) ? *(const f32x4*)(src + (size_t)(rr ? row2 : row) * DM + i * 256 + lane * 4) : (f32x4){0.f, 0.f, 0.f, 0.f}; }
#pragma unroll
    for (int rr = 0; rr < 2; ++rr)
#pragma unroll
      for (int i = 0; i < 4; ++i) ss[rr] += v[rr][i][0] * v[rr][i][0] + v[rr][i][1] * v[rr][i][1] + v[rr][i][2] * v[rr][i][2] + v[rr][i][3] * v[rr][i][3];
    ss[0] = wave_sum(ss[0]); ss[1] = wave_sum(ss[1]);
#pragma unroll
    for (int rr = 0; rr < 2; ++rr) { if (rr == 1 && !has2) break;
      const int rw = rr ? row2 : row; const float r = rsqrtf(ss[rr] * (1.f / DM) + EPS);
      const float* mb = mod + (rw >> 12) * 6144;
#pragma unroll
      for (int i = 0; i < 4; ++i) { const int c = i * 256 + lane * 4;
        if (xcopy) *(f32x4*)(xcopy + (size_t)rw * DM + c) = v[rr][i];
        const f32x4 gg = *(const f32x4*)(g + c), sc = *(const f32x4*)(mb + scale_off + c), sh = *(const f32x4*)(mb + shift_off + c);
        f32x4 y; for (int j = 0; j < 4; ++j) y[j] = v[rr][i][j] * r * gg[j] * (1.f + sc[j]) + sh[j];
        *(bf16x4*)(H + (size_t)rw * DM + c) = pack4(y); } }
  }
}

DEVI void phase_final_norm(float* X, const float* g) {
  TIDL;
  const int wid = tid_ >> 6, lane = tid_ & 63;
  for (int row = blockIdx.x * 8 + wid; row < NT; row += gridDim.x * 8) {
    f32x4 v[4]; float ss = 0.f;
#pragma unroll
    for (int i = 0; i < 4; ++i) { v[i] = *(const f32x4*)(X + (size_t)row * DM + i * 256 + lane * 4); ss += v[i][0] * v[i][0] + v[i][1] * v[i][1] + v[i][2] * v[i][2] + v[i][3] * v[i][3]; }
    ss = wave_sum(ss); const float r = rsqrtf(ss * (1.f / DM) + EPS);
#pragma unroll
    for (int i = 0; i < 4; ++i) { const int c = i * 256 + lane * 4; const f32x4 gg = *(const f32x4*)(g + c);
      f32x4 y; for (int j = 0; j < 4; ++j) y[j] = v[i][j] * r * gg[j];
      *(f32x4*)(X + (size_t)row * DM + c) = y; }
  }
}

DEVI void phase_hg_pre(const Params& p, int l, char* smem) {
  WSP;
  TIDL;
  const bf16_t* U = (const bf16_t*)(ws_ + O_U);
  bf16_t* QT = (bf16_t*)(ws_ + O_QT); bf16_t* KC = (bf16_t*)(ws_ + O_KC); bf16_t* KT = (bf16_t*)(ws_ + O_KT); bf16_t* VT = (bf16_t*)(ws_ + O_VT);
  float* DEC = (float*)(ws_ + O_DEC); const float* lbv = (const float*)(ws_ + O_LBV);
  const int tid = tid_, h = tid >> 7, k = tid & 127;
  const float lb0 = lbv[(0 * 4 + l) * 512 + tid], lb1 = lbv[(1 * 4 + l) * 512 + tid];
  bf16_t* S = (bf16_t*)smem;
  for (int it = blockIdx.x; it < NB * 256; it += gridDim.x) {
    const int b = it >> 8, c = it & 255; const size_t row0 = (size_t)b * SEQ + c * 16;
#pragma unroll
    for (int i = 0; i < 8; ++i) { const int pz = tid + i * 512; const int r = pz >> 8, c8 = (pz & 255) * 8;
      *(u32x4*)(S + r * 2048 + c8) = *(const u32x4*)(U + (row0 + r) * LDU + C_HGQ + c8); }
    __syncthreads();
    float q[16], bc[16], kk[16];
#pragma unroll
    for (int t = 0; t < 16; ++t) q[t] = bf2f(S[t * 2048 + tid]);
    { unsigned vp[8];
#pragma unroll
      for (int t = 0; t < 16; t += 2) vp[t >> 1] = (unsigned)S[t * 2048 + 1536 + tid] | ((unsigned)S[(t + 1) * 2048 + 1536 + tid] << 16);
      bf16_t* d = VT + (((size_t)b * 4 + h) * 128 + k) * SEQ + c * 16;
      *(u32x4*)d = (u32x4){vp[0], vp[1], vp[2], vp[3]}; *(u32x4*)(d + 8) = (u32x4){vp[4], vp[5], vp[6], vp[7]}; }
    float zf[16], zb[16];
#pragma unroll
    for (int t = 0; t < 16; ++t) { zf[t] = bf2f(S[t * 2048 + 512 + tid]); zb[t] = bf2f(S[t * 2048 + 1024 + tid]); }
    __syncthreads();
#pragma unroll
    for (int dir = 0; dir < 2; ++dir) {
      const float lb = dir ? lb1 : lb0; float run = 0.f;
#pragma unroll
      for (int tt = 0; tt < 16; ++tt) { const int t = dir ? 15 - tt : tt;
        const float z = dir ? zb[t] : zf[t];
        float f = lb + (1.f - lb) * sigmoidf_(z); f = fmaxf(f, 1e-30f);
        run += __logf(f); bc[t] = run; kk[t] = 1.f - f; }
      const float tot = run;
      unsigned kp[8];
#pragma unroll
      for (int t = 0; t < 16; ++t) {
        S[((dir * 2 + 0) * 16 + t) * 512 + tid] = f2bf(q[t] * __expf(bc[t]));
        S[((dir * 2 + 1) * 16 + t) * 512 + tid] = f2bf(kk[t] * __expf(fminf(-bc[t], 80.f)));
      }
#pragma unroll
      for (int t = 0; t < 16; t += 2) kp[t >> 1] = cvt_pk_bf16(kk[t] * __expf(tot - bc[t]), kk[t + 1] * __expf(tot - bc[t + 1]));
      bf16_t* d = KT + ((((size_t)dir * NB + b) * 4 + h) * 128 + k) * SEQ + c * 16;
      *(u32x4*)d = (u32x4){kp[0], kp[1], kp[2], kp[3]}; *(u32x4*)(d + 8) = (u32x4){kp[4], kp[5], kp[6], kp[7]};
      DEC[(((size_t)dir * NB + b) * 256 + c) * 512 + tid] = __expf(tot);
    }
    __syncthreads();
#pragma unroll
    for (int i = 0; i < 8; ++i) { const int pz = tid + i * 512; const int arr = pz >> 10, r = (pz >> 6) & 15, c8 = (pz & 63) * 8;
      bf16_t* dst = ((arr & 1) ? KC : QT) + ((size_t)(arr >> 1) * NT + row0 + r) * 512 + c8;
      *(u32x4*)dst = *(const u32x4*)(S + (arr * 16 + r) * 512 + c8); }
    __syncthreads();
  }
}

DEVI void hg_scan_item(const Params& p, int item, char* smem) {
  WSP; TIDL;
  const int dir = item & 1, h = (item >> 1) & 3, b = item >> 3;
  const int w = __builtin_amdgcn_readfirstlane(tid_ >> 6), lane = tid_ & 63, fr = lane & 15, fq = lane >> 4;
  LAS char* shm = (LAS char*)smem;
  bf16_t* U = (bf16_t*)(ws_ + O_U);
  const char* QTb = (const char*)((const bf16_t*)(ws_ + O_QT) + ((size_t)dir * NT + (size_t)b * SEQ) * 512 + h * 128);
  const char* KCb = (const char*)((const bf16_t*)(ws_ + O_KC) + ((size_t)dir * NT + (size_t)b * SEQ) * 512 + h * 128);
  const char* KTb = (const char*)((const bf16_t*)(ws_ + O_KT) + (((size_t)dir * NB + b) * 4 + h) * 128 * SEQ);
  const char* VTb = (const char*)((const bf16_t*)(ws_ + O_VT) + ((size_t)b * 4 + h) * 128 * SEQ);
  const char* DECb = (const char*)((const float*)(ws_ + O_DEC) + ((size_t)dir * NB + b) * 256 * 512 + h * 128);
  const int P = (w & 3) * 64 + lane;
  const unsigned off0 = (unsigned)((P >> 4) * 1024 + (((P & 15) ^ (P >> 4)) * 16));
  const unsigned off1 = (unsigned)((P >> 1) * (SEQ * 2) + (P & 1) * 16);
  const char* g0 = (w < 4) ? QTb : KCb; const char* g1 = (w < 4) ? KTb : VTb;
  const unsigned l0 = ((w < 4) ? 0u : 4096u) + (unsigned)(w & 3) * 1024u, l1 = ((w < 4) ? 8192u : 12288u) + (unsigned)(w & 3) * 1024u;
  constexpr unsigned SLOT = 17408u;
#define HG_ISSUE(cc_, slot_) do { const int ci_ = (cc_) < 256 ? (cc_) : 255; const int c_ = dir ? 255 - ci_ : ci_; const unsigned so_ = (unsigned)(slot_) * SLOT; \
    __builtin_amdgcn_global_load_lds((const unsigned*)(g0 + (size_t)c_ * 16384 + off0), (LAS unsigned*)(shm + so_ + l0), 16, 0, 0); \
    __builtin_amdgcn_global_load_lds((const unsigned*)(g1 + (size_t)c_ * 32 + off1), (LAS unsigned*)(shm + so_ + l1), 16, 0, 0); \
    __builtin_amdgcn_global_load_lds((const unsigned*)(DECb + (size_t)c_ * 2048 + (lane & 31) * 16), (LAS unsigned*)(shm + so_ + 16384u), 16, 0, 0); } while (0)
  f32x4 st[8];
#pragma unroll
  for (int i = 0; i < 8; ++i) st[i] = (f32x4){0.f, 0.f, 0.f, 0.f};
  const int ocol = (dir ? C_OB : C_OF) + h * 128 + w * 16 + fq * 4;
  __builtin_amdgcn_s_barrier();
  for (int cc = 0; cc < 6; ++cc) HG_ISSUE(cc, cc);
  int s_cur = 0, s_iss = 6;
  const unsigned qo0 = (unsigned)(fr * 256 + (fq & 1) * 8);
#pragma nounroll
  for (int cc = 0; cc < 256; ++cc) {
    asm volatile("s_waitcnt vmcnt(15)" ::: "memory");
    __builtin_amdgcn_s_barrier();
    asm volatile("" ::: "memory");
    HG_ISSUE(cc + 6, s_iss); s_iss = (s_iss == 6) ? 0 : s_iss + 1;
    const int c = dir ? 255 - cc : cc; const size_t row0 = (size_t)b * SEQ + c * 16;
    const LAS char* sl = shm + (unsigned)s_cur * SLOT; s_cur = (s_cur == 6) ? 0 : s_cur + 1;
    bf16x8 qf[4], kf[4];
#pragma unroll
    for (int i2 = 0; i2 < 4; ++i2) {
      const unsigned pa = (unsigned)(((i2 * 4 + (fq >> 1)) ^ fr) * 16), pb = (unsigned)(((i2 * 4 + (fq >> 1) + 2) ^ fr) * 16);
      qf[i2] = cat4(*(const LAS bf16x4*)(sl + qo0 + pa), *(const LAS bf16x4*)(sl + qo0 + pb));
      kf[i2] = cat4(*(const LAS bf16x4*)(sl + 4096 + qo0 + pa), *(const LAS bf16x4*)(sl + 4096 + qo0 + pb)); }
    const bf16x4 vf = *(const LAS bf16x4*)(sl + 12288 + (w * 16 + fr) * 32 + fq * 8);
    bf16x4 ktf[8]; f32x4 dc[8];
#pragma unroll
    for (int kt = 0; kt < 8; ++kt) { ktf[kt] = *(const LAS bf16x4*)(sl + 8192 + (kt * 16 + fr) * 32 + fq * 8); dc[kt] = *(const LAS f32x4*)(sl + 16384 + (kt * 16 + fq * 4) * 4); }
    const f32x4 z4 = (f32x4){0.f, 0.f, 0.f, 0.f};
    f32x4 sca = mfma32(kf[0], qf[0], z4), scb = mfma32(kf[2], qf[2], z4);
    f32x4 oa = mfma32(pack8(st[0], st[1]), qf[0], z4), ob = mfma32(pack8(st[4], st[5]), qf[2], z4);
    sca = mfma32(kf[1], qf[1], sca); scb = mfma32(kf[3], qf[3], scb);
    oa = mfma32(pack8(st[2], st[3]), qf[1], oa); ob = mfma32(pack8(st[6], st[7]), qf[3], ob);
    f32x4 sc = sca + scb;
#pragma unroll
    for (int j = 0; j < 4; ++j) { const int s_ = fq * 4 + j, t = fr; const bool ok = dir ? (s_ >= t) : (s_ <= t); sc[j] = ok ? sc[j] : 0.f; }
    f32x4 o = mfma16(vf, pack4(sc), oa);
    o = o + ob;
    *(bf16x4*)(U + (row0 + fr) * LDU + ocol) = pack4(o);
#pragma unroll
    for (int kt = 0; kt < 8; ++kt) { st[kt] = st[kt] * dc[kt]; st[kt] = mfma16(ktf[kt], vf, st[kt]); }
  }
  asm volatile("s_waitcnt vmcnt(0)" ::: "memory");
  __syncthreads();
#undef HG_ISSUE
}

DEVI float one_minus_exp(float x) {
  return x > -0.05f ? -x * (1.f + x * (0.5f + x * (0.16666667f + x * 0.041666668f))) : 1.f - __expf(x);
}
DEVI void pre_tok64(const Params& p, int l, int item, char* smem) {
  WSP; TIDL;
  const int b = item >> 6, tile = item & 63; const int t0 = tile * 64; const size_t brow0 = (size_t)b * SEQ; const size_t row0 = brow0 + t0;
  const int tid = tid_, w = tid >> 6, lane = tid & 63, fr = lane & 15, fq = lane >> 4;
  const bf16_t* U = (const bf16_t*)(ws_ + O_U);
  bf16_t* S = (bf16_t*)smem;
  { const int t = tid >> 3, j4 = (tid & 7) * 4; const bf16x4 raw = ld4(U + (row0 + t) * LDU + C_SSDT + j4);
#pragma unroll
    for (int i = 0; i < 4; ++i) { const int cidx = j4 + i, dir = cidx >> 4, hh = cidx & 15;
      const float dt = softplusf_(bf2f((bf16_t)raw[i]) + p.in[17][(l * 2 + dir) * 16 + hh]);
      ((float*)(ws_ + O_DT))[((size_t)dir * NT + row0 + t) * 16 + hh] = dt;
      ((float*)(ws_ + O_AA))[((size_t)dir * NT + row0 + t) * 16 + hh] = -__expf(p.in[18][(l * 2 + dir) * 16 + hh]) * dt; } }
  u32x4 pre[9];
#define TOK_COL0(blk_) ((blk_) < 2 ? C_SSX + (blk_) * 512 : ((blk_) == 2 ? C_SSB : ((blk_) == 3 ? C_SSC : ((blk_) == 4 ? C_NAV : C_LRX))))
#define TOK_PREFETCH(blk_) do { const int col0_ = TOK_COL0(blk_); _Pragma("unroll") for (int it = 0; it < 9; ++it) { const int i = tid + it * 512; pre[it] = (u32x4){0u, 0u, 0u, 0u}; \
      if (i < 67 * 64) { const int r = i >> 6, c8 = (i & 63) * 8; const int tt = t0 - 2 + r; if (tt >= 0 && tt < SEQ) pre[it] = *(const u32x4*)(U + (brow0 + tt) * LDU + col0_ + c8); } } } while (0)
  TOK_PREFETCH(0);
#pragma nounroll
  for (int blk = 0; blk < 6; ++blk) {
#pragma unroll
    for (int it = 0; it < 9; ++it) { const int i = tid + it * 512; if (i < 67 * 64) { const int r = i >> 6, c8 = (i & 63) * 8; *(u32x4*)(S + r * 520 + c8) = pre[it]; } }
    __syncthreads();
    if (blk < 5) TOK_PREFETCH(blk + 1);
    float w0 = 0.f, w1 = 0.f, w2 = 1.f, w3 = 0.f, bias = 0.f;
    if (blk < 4) { const int ch = blk * 512 + tid; const float* cw = p.in[15] + (size_t)l * 4 * 2048; w0 = cw[ch]; w1 = cw[2048 + ch]; w2 = cw[4096 + ch]; w3 = cw[6144 + ch]; bias = p.in[16][(size_t)l * 2048 + ch]; }
    else if (blk == 5) { const float* cw = p.in[10] + (size_t)l * 4 * 512; w0 = cw[tid]; w1 = cw[512 + tid]; w2 = cw[1024 + tid]; w3 = cw[1536 + tid]; bias = p.in[11][l * 512 + tid]; }
    bf16_t* tdst = nullptr;
    if (blk < 2) { const int ch = blk * 512 + tid; tdst = (bf16_t*)(ws_ + O_XST) + (((size_t)b * 16 + (ch >> 6)) * 64 + (ch & 63)) * SEQ + t0; }
    else if (blk == 2) tdst = (bf16_t*)(ws_ + O_BT) + (((size_t)b * 4 + (tid >> 7)) * 128 + (tid & 127)) * SEQ + t0;
    else if (blk == 4) tdst = (bf16_t*)(ws_ + O_VTN) + (((size_t)b * 8 + (tid >> 6)) * 64 + (tid & 63)) * SEQ + t0;
    float xm2 = bf2f(S[0 * 520 + tid]), xm1 = bf2f(S[1 * 520 + tid]), x0 = bf2f(S[2 * 520 + tid]);
    for (int t8 = 0; t8 < 64; t8 += 8) { float y[8];
#pragma unroll
      for (int i = 0; i < 8; ++i) { const float x1 = bf2f(S[(t8 + i + 3) * 520 + tid]); float v = w0 * xm2 + w1 * xm1 + w2 * x0 + w3 * x1 + bias;
        if (blk < 4) v = siluf_(v);
        y[i] = v; xm2 = xm1; xm1 = x0; x0 = x1; }
      if (tdst) *(u32x4*)(tdst + t8) = (u32x4){cvt_pk_bf16(y[0], y[1]), cvt_pk_bf16(y[2], y[3]), cvt_pk_bf16(y[4], y[5]), cvt_pk_bf16(y[6], y[7])};
      if (blk == 2 || blk == 3 || blk == 5) {
#pragma unroll
        for (int i = 0; i < 8; ++i) S[(t8 + i) * 520 + tid] = f2bf(y[i]); }
    }
    __syncthreads();
    if (blk == 2 || blk == 3) {
      bf16_t* dst = (bf16_t*)(ws_ + (blk == 2 ? O_BM : O_CM));
#pragma unroll
      for (int it = 0; it < 8; ++it) { const int i = tid + it * 512; const int r = i >> 6, c8 = (i & 63) * 8;
        *(u32x4*)(dst + (row0 + r) * 512 + c8) = *(const u32x4*)(S + r * 520 + c8); }
      __syncthreads();
    }
  }
  { const bf16_t* xt = S;
    float* scr = (float*)(smem + 69888) + w * 2048;
    const bf16_t* WG = (const bf16_t*)(ws_ + O_W) + W_LRG;
    _Float16* HL = (_Float16*)(ws_ + O_HL); _Float16* PP = (_Float16*)(ws_ + O_PP);
    const int n = w;
    for (int dir = 0; dir < 2; ++dir) {
      bf16x8 wf[2][4][2];
#pragma unroll
      for (int g = 0; g < 2; ++g)
#pragma unroll
        for (int nt_ = 0; nt_ < 4; ++nt_)
#pragma unroll
          for (int ks = 0; ks < 2; ++ks) wf[g][nt_][ks] = ld8(WG + ((size_t)(nt_ * 16 + fr) * 32 + ((dir * 2 + g) * 8 + n)) * 64 + ks * 32 + fq * 8);
      float gbr[4], gbi[4], sp[4];
#pragma unroll
      for (int nt_ = 0; nt_ < 4; ++nt_) { const int ch = n * 64 + nt_ * 16 + fr;
        gbr[nt_] = p.in[13][((l * 2 + dir) * 2 + 0) * 512 + ch]; gbi[nt_] = p.in[13][((l * 2 + dir) * 2 + 1) * 512 + ch];
        sp[nt_] = softplusf_(-p.in[14][(l * 2 + dir) * 512 + ch]); }
      float hrun = 0.f, prun = 1.f;
      for (int mm = 0; mm < 4; ++mm) { const int mi = dir ? 3 - mm : mm;
        bf16x8 af[2];
#pragma unroll
        for (int ks = 0; ks < 2; ++ks) af[ks] = *(const bf16x8*)(xt + (mi * 16 + fr) * 520 + n * 64 + ks * 32 + fq * 8);
#pragma unroll
        for (int nt_ = 0; nt_ < 4; ++nt_) {
          f32x4 ar = (f32x4){0.f, 0.f, 0.f, 0.f}, ai_ = (f32x4){0.f, 0.f, 0.f, 0.f};
#pragma unroll
          for (int ks = 0; ks < 2; ++ks) { ar = mfma32(af[ks], wf[0][nt_][ks], ar); ai_ = mfma32(af[ks], wf[1][nt_][ks], ai_); }
#pragma unroll
          for (int j = 0; j < 4; ++j) { const int tl = fq * 4 + j, e = nt_ * 16 + fr;
            const float xv = bf2f(xt[(mi * 16 + tl) * 520 + n * 64 + e]);
            const float rg = sigmoidf_(ar[j] + gbr[nt_]), ig = sigmoidf_(ai_[j] + gbi[nt_]);
            const float la = -8.f * rg * sp[nt_]; const float a = __expf(la);
            const float mult = __builtin_amdgcn_sqrtf(fmaxf(one_minus_exp(2.f * la), 0.f));
            scr[tl * 64 + e] = a; scr[1024 + tl * 64 + e] = mult * ig * xv; }
        }
        __builtin_amdgcn_wave_barrier(); asm volatile("s_waitcnt lgkmcnt(0)" ::: "memory");
        for (int t2 = 0; t2 < 16; ++t2) { const int tl = dir ? 15 - t2 : t2;
          const float a = scr[tl * 64 + lane], u = scr[1024 + tl * 64 + lane];
          hrun = a * hrun + u; prun *= a;
          const size_t o = ((size_t)dir * NT + row0 + mi * 16 + tl) * 512 + n * 64 + lane;
          HL[o] = (_Float16)hrun; PP[o] = (_Float16)prun; }
        __builtin_amdgcn_wave_barrier(); asm volatile("s_waitcnt lgkmcnt(0)" ::: "memory");
      }
      const size_t co = (((size_t)dir * NB + b) * 64 + tile) * 512 + n * 64 + lane;
      ((float*)(ws_ + O_CP))[co] = prun; ((float*)(ws_ + O_CH))[co] = hrun;
    }
    __syncthreads();
  }
}

DEVI void lru_carry_item(const Params& p, int item) {
  TIDL;
  WSP;
  const int g = item * 512 + tid_; const int dir = g >> 11, b = (g >> 9) & 3, ch = g & 511;
  const float* CP = (const float*)(ws_ + O_CP); const float* CH = (const float*)(ws_ + O_CH); float* CIN = (float*)(ws_ + O_CIN);
  float run = 0.f;
  for (int i = 0; i < 64; ++i) { const int tile = dir ? 63 - i : i; const size_t o = (((size_t)dir * NB + b) * 64 + tile) * 512 + ch;
    CIN[o] = run; run = CP[o] * run + CH[o]; }
}

DEVI void ssd_diag_item(const Params& p, int l, int item, char* smem) {
  TIDL;
  WSP;
  const int n = item & 31, g = (item >> 5) & 3, b = item >> 7;
  const int tid = tid_, w = __builtin_amdgcn_readfirstlane(tid >> 6), lane = tid & 63, fr = lane & 15, fq = lane >> 4;
  bf16_t* U = (bf16_t*)(ws_ + O_U);
  const bf16_t* BM = (const bf16_t*)(ws_ + O_BM) + g * 128; const bf16_t* CM = (const bf16_t*)(ws_ + O_CM) + g * 128;
  float* acum = (float*)smem;
  float* dtv = acum + 1024;
  float* farr = dtv + 1024;
  const size_t row0 = (size_t)b * SEQ + n * 128; const int tc0 = n * 128;
  {
    const int dir = w & 1, hh = g * 4 + (w >> 1);
    const float* DT = (const float*)(ws_ + O_DT) + (size_t)dir * NT * 16 + hh; const float* AA = (const float*)(ws_ + O_AA) + (size_t)dir * NT * 16 + hh;
    const float a0 = AA[(row0 + 2 * lane) * 16], a1 = AA[(row0 + 2 * lane + 1) * 16];
    const float d0 = DT[(row0 + 2 * lane) * 16], d1 = DT[(row0 + 2 * lane + 1) * 16];
    float s_ = a0 + a1, inc = s_;
    for (int o = 1; o < 64; o <<= 1) { const float t = __shfl_up(inc, o); if (lane >= o) inc += t; }
    const float total = __shfl(inc, 63); const float exc = inc - s_;
    float c0, c1;
    if (!dir) { c0 = exc + a0; c1 = exc + a0 + a1; } else { c0 = total - exc; c1 = total - exc - a0; }
    const float s0 = c0 * 1.4426950408889634f, s1 = c1 * 1.4426950408889634f;
    acum[w * 128 + 2 * lane] = s0; acum[w * 128 + 2 * lane + 1] = s1;
    dtv[w * 128 + 2 * lane] = d0; dtv[w * 128 + 2 * lane + 1] = d1;
    { const int tl = lane >> 3;
      const float rf = __shfl(s1, tl * 8 + 7), rb = __shfl(s0, tl * 8); const float R = dir ? rb : rf;
      farr[w * 128 + 2 * lane] = __builtin_amdgcn_exp2f(R - s0) * d0; farr[w * 128 + 2 * lane + 1] = __builtin_amdgcn_exp2f(R - s1) * d1; }
  }
  int q = w * 16 + fr; asm volatile("" : "+v"(q));
  f32x4 cb[8];
  { bf16x8 cf[4];
#pragma unroll
    for (int ks = 0; ks < 4; ++ks) cf[ks] = ld8(CM + (row0 + q) * 512 + ks * 32 + fq * 8);
#pragma unroll
    for (int kt = 0; kt < 8; ++kt) { cb[kt] = (f32x4){0.f, 0.f, 0.f, 0.f};
#pragma unroll
      for (int ks = 0; ks < 4; ++ks) cb[kt] = mfma32(ld8(BM + (row0 + kt * 16 + fr) * 512 + ks * 32 + fq * 8), cf[ks], cb[kt]); } }
  __syncthreads();
#pragma nounroll
  for (int r = 0; r < 4; ++r) {
    const int hh = g * 4 + r;
    const bf16_t* XST = (const bf16_t*)(ws_ + O_XST) + ((size_t)b * 16 + hh) * 64 * SEQ;
    const float skip = p.in[19][l * 16 + hh];
    const float* acf = acum + (r * 2) * 128; const float* acb = acf + 128; const float* dtf = dtv + (r * 2) * 128; const float* dtb = dtf + 128; const float* ff = farr + (r * 2) * 128; const float* fb = ff + 128;
    const float aqf = acf[q], aqb = acb[q];
    f32x4 y[4];
#pragma unroll
    for (int pt = 0; pt < 4; ++pt) y[pt] = (f32x4){0.f, 0.f, 0.f, 0.f};
    bf16x8 xf[4][4]; bf16_t xsk[4][4];
#pragma unroll
    for (int c2 = 0; c2 < 4; ++c2)
#pragma unroll
      for (int pt = 0; pt < 4; ++pt) { const bf16_t* xp = XST + (size_t)(pt * 16 + fr) * SEQ + tc0 + c2 * 32 + fq * 4; xf[c2][pt] = cat4(ld4(xp), ld4(xp + 16)); }
#pragma unroll
    for (int pt = 0; pt < 4; ++pt)
#pragma unroll
      for (int j = 0; j < 4; ++j) xsk[pt][j] = XST[(size_t)(pt * 16 + fq * 4 + j) * SEQ + tc0 + q];
#pragma unroll
    for (int c2 = 0; c2 < 4; ++c2) {
      f32x4 mt[2];
#pragma unroll
      for (int hf = 0; hf < 2; ++hf) { const int kt = 2 * c2 + hf; const int kb = kt * 16 + fq * 4;
        if (kt == w) {
          const f32x4 af = *(const f32x4*)(acf + kb), ab = *(const f32x4*)(acb + kb), df = *(const f32x4*)(dtf + kb), db = *(const f32x4*)(dtb + kb);
#pragma unroll
          for (int j = 0; j < 4; ++j) { const int k = kb + j; const bool lo = k < q;
            const float arg = lo ? (aqf - af[j]) : (aqb - ab[j]);
            float wgt_ = __builtin_amdgcn_exp2f(arg) * (lo ? df[j] : db[j]);
            wgt_ += (k == q) ? df[j] : 0.f;
            mt[hf][j] = cb[kt][j] * wgt_; }
        } else {
          const bool fw = kt < w;
          const float E = __builtin_amdgcn_exp2f(fw ? (aqf - acf[kt * 16 + 15]) : (aqb - acb[kt * 16]));
          const f32x4 F = *(const f32x4*)((fw ? ff : fb) + kb);
#pragma unroll
          for (int j = 0; j < 4; ++j) mt[hf][j] = cb[kt][j] * (E * F[j]); } }
      const bf16x8 mf = pack8(mt[0], mt[1]);
#pragma unroll
      for (int pt = 0; pt < 4; ++pt) y[pt] = mfma32(xf[c2][pt], mf, y[pt]);
    }
    const int ycol = (hh < 8 ? C_YD0 : C_YD1) + (hh & 7) * 64;
#pragma unroll
    for (int pt = 0; pt < 4; ++pt) { f32x4 v = y[pt];
#pragma unroll
      for (int j = 0; j < 4; ++j) v[j] += skip * bf2f(xsk[pt][j]);
      *(bf16x4*)(U + (row0 + q) * LDU + ycol + pt * 16 + fq * 4) = pack4(v); }
  }
  __syncthreads();
}

DEVI void ssd_scan_item(const Params& p, int l, int item, char* smem) {
  TIDL;
  WSP;
  const int dir = item & 1, hh = (item >> 1) & 15, b = item >> 5, g = hh >> 2;
  const int tid = tid_, w = tid >> 6, lane = tid & 63, fr = lane & 15, fq = lane >> 4;
  bf16_t* U = (bf16_t*)(ws_ + O_U);
  const bf16_t* XST = (const bf16_t*)(ws_ + O_XST) + ((size_t)b * 16 + hh) * 64 * SEQ;
  const bf16_t* CM = (const bf16_t*)(ws_ + O_CM) + g * 128;
  const bf16_t* BT = (const bf16_t*)(ws_ + O_BT) + ((size_t)b * 4 + g) * 128 * SEQ;
  const float* DT = (const float*)(ws_ + O_DT) + (size_t)dir * NT * 16 + hh; const float* AA = (const float*)(ws_ + O_AA) + (size_t)dir * NT * 16 + hh;
  float* acum = (float*)smem;
  float* wgt = acum + 256;
  float* tot = wgt + 256;
  bf16_t* stl = (bf16_t*)(smem + 4096);
  for (int i = tid; i < 64 * 136; i += 512) stl[i] = 0;
  f32x4 stT[4];
#pragma unroll
  for (int i = 0; i < 4; ++i) stT[i] = (f32x4){0.f, 0.f, 0.f, 0.f};
  const int q = w * 16 + fr;
  bf16x8 cf[4]; float a0 = 0.f, a1 = 0.f, d0 = 0.f, d1 = 0.f;
#define SSD_LOADC(nn_, CF, A0, A1, D0, D1) do { const int n_ = dir ? 31 - (nn_) : (nn_); const size_t r0_ = (size_t)b * SEQ + n_ * 128; \
    _Pragma("unroll") for (int ks = 0; ks < 4; ++ks) CF[ks] = ld8(CM + (r0_ + q) * 512 + ks * 32 + fq * 8); \
    if (w == 0) { A0 = AA[(r0_ + 2 * lane) * 16]; A1 = AA[(r0_ + 2 * lane + 1) * 16]; D0 = DT[(r0_ + 2 * lane) * 16]; D1 = DT[(r0_ + 2 * lane + 1) * 16]; } } while (0)
  SSD_LOADC(0, cf, a0, a1, d0, d1);
#pragma nounroll
  for (int nn = 0; nn < 32; ++nn) {
    const int n = dir ? 31 - nn : nn, par = nn & 1; const size_t row0 = (size_t)b * SEQ + n * 128; const int tc0 = n * 128;
    bf16x8 br[4], xs[4][4];
#pragma unroll
    for (int ks = 0; ks < 4; ++ks) { br[ks] = ld8(BT + (size_t)(w * 16 + fr) * SEQ + tc0 + ks * 32 + fq * 8);
#pragma unroll
      for (int pt = 0; pt < 4; ++pt) xs[ks][pt] = ld8(XST + (size_t)(pt * 16 + fr) * SEQ + tc0 + ks * 32 + fq * 8); }
    bf16x8 cfn[4]; float a0n = 0.f, a1n = 0.f, d0n = 0.f, d1n = 0.f;
    { const int nx = nn < 31 ? nn + 1 : 31; SSD_LOADC(nx, cfn, a0n, a1n, d0n, d1n); }
    if (w == 0) {
      float s_ = a0 + a1, inc = s_;
      for (int o = 1; o < 64; o <<= 1) { const float t = __shfl_up(inc, o); if (lane >= o) inc += t; }
      const float total = __shfl(inc, 63); const float exc = inc - s_;
      float c0, c1;
      if (!dir) { c0 = exc + a0; c1 = exc + a0 + a1; } else { c0 = total - exc; c1 = total - exc - a0; }
      acum[par * 128 + 2 * lane] = c0; acum[par * 128 + 2 * lane + 1] = c1;
      wgt[par * 128 + 2 * lane] = __expf(total - c0) * d0; wgt[par * 128 + 2 * lane + 1] = __expf(total - c1) * d1;
      if (lane == 0) tot[par] = total;
    }
    __syncthreads();
    const float* ac = acum + par * 128; const float* wg = wgt + par * 128;
    const float acq = ac[q];
    f32x4 y[4];
#pragma unroll
    for (int pt = 0; pt < 4; ++pt) { y[pt] = (f32x4){0.f, 0.f, 0.f, 0.f};
#pragma unroll
      for (int ks = 0; ks < 4; ++ks) y[pt] = mfma32(*(const bf16x8*)(stl + (pt * 16 + fr) * 136 + ks * 32 + fq * 8), cf[ks], y[pt]); }
    const float eq = __expf(acq);
#pragma unroll
    for (int pt = 0; pt < 4; ++pt) *(bf16x4*)(U + (row0 + q) * LDU + (dir ? C_YSB : C_YSF) + hh * 64 + pt * 16 + fq * 4) = pack4(y[pt] * eq);
    const float et = __expf(tot[par]);
#pragma unroll
    for (int pt = 0; pt < 4; ++pt) stT[pt] = stT[pt] * et;
#pragma unroll
    for (int ks = 0; ks < 4; ++ks) {
      f32x4 lo, hi;
#pragma unroll
      for (int i = 0; i < 4; ++i) { lo[i] = bf2f((bf16_t)br[ks][i]) * wg[ks * 32 + fq * 8 + i]; hi[i] = bf2f((bf16_t)br[ks][4 + i]) * wg[ks * 32 + fq * 8 + 4 + i]; }
      const bf16x8 bw = pack8(lo, hi);
#pragma unroll
      for (int pt = 0; pt < 4; ++pt) stT[pt] = mfma32(bw, xs[ks][pt], stT[pt]);
    }
    __syncthreads();
#pragma unroll
    for (int pt = 0; pt < 4; ++pt) *(bf16x4*)(stl + (pt * 16 + fr) * 136 + w * 16 + fq * 4) = pack4(stT[pt]);
#pragma unroll
    for (int ks = 0; ks < 4; ++ks) cf[ks] = cfn[ks];
    a0 = a0n; a1 = a1n; d0 = d0n; d1 = d1n;
  }
#undef SSD_LOADC
  __syncthreads();
}

DEVI void na_item(const Params& p, int l, int item, const char* smem) {
  TIDL;
  WSP;
  const int w = tid_ >> 6, lane = tid_ & 63, fr = lane & 15, fq = lane >> 4;
  const int m = item & 3, r = (item >> 2) & 63, b = item >> 8, hd = w;
  bf16_t* U = (bf16_t*)(ws_ + O_U);
  const bf16_t* VTN = (const bf16_t*)(ws_ + O_VTN) + ((size_t)b * 8 + hd) * 64 * SEQ;
  const float* rpb = (const float*)(smem + 16384) + hd * 465;
  int kr0 = r - 4; kr0 = kr0 < 0 ? 0 : (kr0 > 56 ? 56 : kr0);
  int kc0 = m * 16 - 8; kc0 = kc0 < 0 ? 0 : (kc0 > 32 ? 32 : kc0);
  const size_t qrow = (size_t)b * SEQ + r * 64 + m * 16 + fr;
  bf16x8 qf[2];
#pragma unroll
  for (int ks = 0; ks < 2; ++ks) qf[ks] = ld8(U + qrow * LDU + C_NAQ + hd * 64 + ks * 32 + fq * 8);
  const int qcol = m * 16 + fr; int cst = qcol - 8; cst = cst < 0 ? 0 : (cst > 48 ? 48 : cst);
  f32x4 s[16]; float mx = -1e30f;
#pragma unroll
  for (int a = 0; a < 8; ++a)
#pragma unroll
    for (int hf = 0; hf < 2; ++hf) { const int ti = a * 2 + hf;
      const size_t krow = (size_t)b * SEQ + (kr0 + a) * 64 + kc0 + hf * 16 + fr;
      f32x4 acc = (f32x4){0.f, 0.f, 0.f, 0.f};
#pragma unroll
      for (int ks = 0; ks < 2; ++ks) acc = mfma32(ld8(U + krow * LDU + C_NAK + hd * 64 + ks * 32 + fq * 8), qf[ks], acc);
      const int dr = kr0 + a - r + 7;
#pragma unroll
      for (int j = 0; j < 4; ++j) { const int kcol = kc0 + hf * 16 + fq * 4 + j; const bool ok = (kcol >= cst) && (kcol < cst + 16);
        int dcc = kcol - qcol; dcc = dcc < -15 ? -15 : (dcc > 15 ? 15 : dcc);
        const float v = ok ? acc[j] * 0.125f + rpb[dr * 31 + dcc + 15] : -1e30f; acc[j] = v; mx = fmaxf(mx, v); }
      s[ti] = acc; }
  bf16x8 vpre[4][4];
#pragma unroll
  for (int a = 0; a < 4; ++a)
#pragma unroll
    for (int dt = 0; dt < 4; ++dt) { const bf16_t* vp = VTN + (size_t)(dt * 16 + fr) * SEQ + (kr0 + a) * 64 + kc0 + fq * 4; vpre[a][dt] = cat4(ld4(vp), ld4(vp + 16)); }
  mx = fmaxf(mx, __shfl_xor(mx, 16)); mx = fmaxf(mx, __shfl_xor(mx, 32));
  float sum = 0.f;
#pragma unroll
  for (int ti = 0; ti < 16; ++ti)
#pragma unroll
    for (int j = 0; j < 4; ++j) { const float e = s[ti][j] > -1e29f ? __expf(s[ti][j] - mx) : 0.f; s[ti][j] = e; sum += e; }
  sum += __shfl_xor(sum, 16); sum += __shfl_xor(sum, 32);
  const float inv = __builtin_amdgcn_rcpf(sum);
  f32x4 o[4];
#pragma unroll
  for (int dt = 0; dt < 4; ++dt) o[dt] = (f32x4){0.f, 0.f, 0.f, 0.f};
#pragma unroll
  for (int a = 0; a < 8; ++a) { const bf16x8 pf = pack8(s[2 * a], s[2 * a + 1]);
#pragma unroll
    for (int dt = 0; dt < 4; ++dt) { const bf16_t* vp = VTN + (size_t)(dt * 16 + fr) * SEQ + (kr0 + a) * 64 + kc0 + fq * 4;
      o[dt] = mfma32(a < 4 ? vpre[a & 3][dt] : cat4(ld4(vp), ld4(vp + 16)), pf, o[dt]); } }
#pragma unroll
  for (int dt = 0; dt < 4; ++dt) *(bf16x4*)(U + qrow * LDU + C_YNA + hd * 64 + dt * 16 + fq * 4) = pack4(o[dt] * inv);
}

DEVI void phase_finalize(const Params& p, int l) {
  TIDL;
  WSP;
  const int wid = tid_ >> 6, lane = tid_ & 63;
  bf16_t* U = (bf16_t*)(ws_ + O_U);
  const _Float16* HL = (const _Float16*)(ws_ + O_HL); const _Float16* PP = (const _Float16*)(ws_ + O_PP); const float* CIN = (const float*)(ws_ + O_CIN);
  const float* hgn = p.in[8] + l * 512; const float* ssn = p.in[20] + l * 1024;
  for (int row = blockIdx.x * 8 + wid; row < NT; row += gridDim.x * 8) {
    bf16_t* ur = U + (size_t)row * LDU; const int b = row >> 12, tile = (row & 4095) >> 6;
    {
      const int c = lane * 16; float y[16], ss = 0.f;
#pragma unroll
      for (int hf = 0; hf < 2; ++hf) { const bf16x8 yf = ld8(ur + C_YSF + c + hf * 8), yb = ld8(ur + C_YSB + c + hf * 8), zz = ld8(ur + C_SSZ + c + hf * 8), yd = ld8(ur + (c < 512 ? C_YD0 + c : C_YD1 + c - 512) + hf * 8);
#pragma unroll
        for (int i = 0; i < 8; ++i) { const float v = (bf2f((bf16_t)yf[i]) + bf2f((bf16_t)yb[i]) + bf2f((bf16_t)yd[i])) * siluf_(bf2f((bf16_t)zz[i])); y[hf * 8 + i] = v; ss += v * v; } }
      ss = wave_sum(ss); const float r = rsqrtf(ss * (1.f / 1024.f) + EPS);
#pragma unroll
      for (int hf = 0; hf < 2; ++hf) { float t[8];
#pragma unroll
        for (int i = 0; i < 8; ++i) t[i] = y[hf * 8 + i] * r * ssn[c + hf * 8 + i];
        *(u32x4*)(ur + C_YSS + c + hf * 8) = (u32x4){cvt_pk_bf16(t[0], t[1]), cvt_pk_bf16(t[2], t[3]), cvt_pk_bf16(t[4], t[5]), cvt_pk_bf16(t[6], t[7])}; } }
    {
      const int c = lane * 8; const bf16x8 of = ld8(ur + C_OF + c), ob = ld8(ur + C_OB + c), gg = ld8(ur + C_HGG + c);
      float o[8], ss = 0.f;
#pragma unroll
      for (int i = 0; i < 8; ++i) { o[i] = bf2f((bf16_t)of[i]) + bf2f((bf16_t)ob[i]); ss += o[i] * o[i]; }
      ss += __shfl_xor(ss, 1); ss += __shfl_xor(ss, 2); ss += __shfl_xor(ss, 4); ss += __shfl_xor(ss, 8);
      const float r = rsqrtf(ss * (1.f / 128.f) + EPS); float y[8];
#pragma unroll
      for (int i = 0; i < 8; ++i) y[i] = o[i] * r * hgn[c + i] * siluf_(bf2f((bf16_t)gg[i]));
      *(u32x4*)(ur + C_YHG + c) = (u32x4){cvt_pk_bf16(y[0], y[1]), cvt_pk_bf16(y[2], y[3]), cvt_pk_bf16(y[4], y[5]), cvt_pk_bf16(y[6], y[7])}; }
    {
      typedef _Float16 h8 __attribute__((ext_vector_type(8)));
      const int c = lane * 8; const bf16x8 gg = ld8(ur + C_LRG + c); float y[8];
      float hs[8] = {0.f, 0.f, 0.f, 0.f, 0.f, 0.f, 0.f, 0.f};
#pragma unroll
      for (int dir = 0; dir < 2; ++dir) { const size_t o = ((size_t)dir * NT + row) * 512 + c;
        const h8 hl = *(const h8*)(HL + o), pp = *(const h8*)(PP + o);
        const float* ci = CIN + (((size_t)dir * NB + b) * 64 + tile) * 512 + c; const f32x4 c0 = *(const f32x4*)ci, c1 = *(const f32x4*)(ci + 4);
#pragma unroll
        for (int i = 0; i < 8; ++i) hs[i] += (float)hl[i] + (float)pp[i] * (i < 4 ? c0[i] : c1[i - 4]); }
#pragma unroll
      for (int i = 0; i < 8; ++i) y[i] = hs[i] * gelu_tanh(bf2f((bf16_t)gg[i]));
      *(u32x4*)(ur + C_YLR + c) = (u32x4){cvt_pk_bf16(y[0], y[1]), cvt_pk_bf16(y[2], y[3]), cvt_pk_bf16(y[4], y[5]), cvt_pk_bf16(y[6], y[7])}; }
  }
}

__global__ void __launch_bounds__(512) mk(Params p) {
  cg::grid_group grid = cg::this_grid();
  extern __shared__ __attribute__((aligned(16))) char smem[];
  LAS char* shm = (LAS char*)smem;
  volatile int& s_item = *(volatile int*)(smem + 139264 - 16);
  unsigned* bar = (unsigned*)(p.ws + O_BAR); unsigned epoch = 0; (void)epoch;
  volatile LAS unsigned* xst = (volatile LAS unsigned*)(shm + 139264 - 32);
  if (threadIdx.x == 0) { xst[0] = 0u; xst[1] = 0u; }
  __syncthreads();
  const XcdBarrier xb = xcd_barrier_post(bar, xst);
#if DIAG
  unsigned long long tprev_ = wall_clock64(); unsigned accx_ = 0, accy_ = 0;
#define TICK(i) { const unsigned long long now_ = wall_clock64(); const unsigned d_ = (unsigned)(now_ - tprev_); tprev_ = now_; if ((i) == TX) accx_ += d_; if ((i) == TY) accy_ += d_; }
#else
#define TICK(i)
#endif
  bf16_t* U = (bf16_t*)(p.ws + O_U); bf16_t* H = (bf16_t*)(p.ws + O_H); bf16_t* W = (bf16_t*)(p.ws + O_W);
  float* MF = (float*)(p.ws + O_MF32); bf16_t* HID = (bf16_t*)(p.ws + O_HID);
  const float* mod = (const float*)(p.ws + O_MOD);
  float* X = p.X;

  REP(0) {
#ifndef NO_MOD
  phase_mod(p, smem);
#endif
#ifndef NO_WCONV
  phase_wconv(p, 0, smem);
#endif
  }
  grid.sync();
  TICK(0)

  for (int l = 0; l < NL; ++l) {
    const float* modl = mod + (size_t)l * 4 * 6144;
    REP(1) {
#ifndef NO_WCONV
    if (l > 0) phase_wconv(p, l, smem);
#endif
#ifndef NO_NORM
    phase_norm(l == 0 ? p.in[0] : X, l == 0 ? X : nullptr, p.in[4] + l * DM, modl, 0, 1024, H);
#endif
    }
    gsync(bar, epoch); if ((DUP >> 20) & 1) gsync(bar, epoch); TICK(1)
    REP(2) {
#ifndef NO_GEMM1
      gemm_stream(shm, DM, DM,
        [&](int i, GUnit& g) { const int u = blockIdx.x + i * (int)gridDim.x; if (u >= 64 * 49) return false; int pm, pn; tile_of(u, 64, 49, pm, pn);
          g.brow = pm * 256; g.bcol = pn * 256; g.nt = 16; g.aux = 0; g.keep = 0; g.cA = (const char*)(H + (size_t)g.brow * DM); g.cB = (const char*)(W + W_IN + (size_t)g.bcol * DM); return true; },
        [&](const GUnit& g, f32x4 (&acc)[2][2][4][2]) { const int brow = g.brow, bcol = g.bcol;
          EPI_LOOP( *(bf16x4*)(U + (size_t)row * LDU + col) = pack4(v); ) });
#endif
    }
    gsync(bar, epoch); if ((DUP >> 20) & 1) gsync(bar, epoch); TICK(2)
    REP(11) {
#ifndef NO_HGPRE
    phase_hg_pre(p, l, smem);
#endif
    }
#if DIAG
    gsync(bar, epoch); if ((DUP >> 20) & 1) gsync(bar, epoch); TICK(11)
#endif
    REP(3) {
#ifndef NO_TOK64
    for (int it = blockIdx.x; it < 256; it += gridDim.x) pre_tok64(p, l, it, smem);
#endif
    }
    gsync(bar, epoch); if ((DUP >> 20) & 1) gsync(bar, epoch); TICK(3)
    { const int nb = gridDim.x;
#if DIAG
      for (int it = blockIdx.x; it < 128; it += nb) ssd_scan_item(p, l, it, smem);
      gsync(bar, epoch); if ((DUP >> 20) & 1) gsync(bar, epoch); TICK(14)
      for (int it = blockIdx.x + 128; it < 128 + 32 + 8; it += nb) {
#else
      for (int it = blockIdx.x; it < 128 + 32 + 8; it += nb) {
#endif
        if (it < 128) {
          REP(14) {
#ifndef NO_SSD
          ssd_scan_item(p, l, it, smem);
#endif
          }
        } else if (it < 160) {
          REP(12) {
#ifndef NO_HGSCAN
          hg_scan_item(p, it - 128, smem);
#endif
          }
        } else lru_carry_item(p, it - 160); }
#if DIAG
      gsync(bar, epoch); if ((DUP >> 20) & 1) gsync(bar, epoch); TICK(12)
#endif
      { float* rl = (float*)(smem + 16384); const float* rg = p.in[9] + (size_t)l * 8 * 465; __syncthreads();
        for (int i = threadIdx.x; i < 8 * 465; i += 512) rl[i] = rg[i]; __syncthreads(); }
      REP(4) { unsigned* q = bar + 16 + l + 8 * rep_;
      volatile int* slot = &s_item;
      __syncthreads(); if (threadIdx.x == 0) slot[0] = (int)atomicAdd(q, 1u); __syncthreads();
      int it = slot[0], par = 0;
      while (it < 512 + 1024) {
        if (threadIdx.x == 0) slot[par ^ 1] = (int)atomicAdd(q, 1u);
#ifndef NO_NA
        if (it < 512) ssd_diag_item(p, l, it, smem); else na_item(p, l, it - 512, smem);
#endif
        __syncthreads(); par ^= 1; it = slot[par];
      } } }
    gsync(bar, epoch); if ((DUP >> 20) & 1) gsync(bar, epoch); TICK(4)
    REP(5) {
#ifndef NO_FIN
    phase_finalize(p, l);
#endif
    }
    gsync(bar, epoch); if ((DUP >> 20) & 1) gsync(bar, epoch); TICK(5)
    REP(6) {
#ifndef NO_GEMM2
      gemm_stream(shm, LDU, DM,
        [&](int i, GUnit& g) { const int u = blockIdx.x + (i >> 2) * (int)gridDim.x, seg = i & 3; if (u >= 64 * 4) return false; int pm, pn; tile_of(u, 64, 4, pm, pn);
          g.brow = pm * 256; g.bcol = pn * 256; g.nt = seg == 3 ? 16 : 8; g.aux = seg; g.keep = seg < 3;
          const int acol = seg == 0 ? C_YHG : (seg == 1 ? C_YNA : (seg == 2 ? C_YLR : C_YSS));
          g.cA = (const char*)(U + (size_t)g.brow * LDU + acol); g.cB = (const char*)(W + W_BRHG + (size_t)seg * 1024 * 1024 + (size_t)g.bcol * DM); return true; },
        [&](const GUnit& g, f32x4 (&acc)[2][2][4][2]) { const int brow = g.brow, bcol = g.bcol, seg = g.aux;
          if (seg < 3) {
#pragma unroll
            for (int ai = 0; ai < 2; ++ai)
#pragma unroll
              for (int m = 0; m < 4; ++m) { TIDL; const int wid = __builtin_amdgcn_readfirstlane(tid_ >> 6), lane = tid_ & 63, wr = wid >> 2, wc = wid & 3, fr = lane & 15, fq = lane >> 4;
                int row = brow + ai * 128 + wr * 64 + m * 16 + fr; asm volatile("" : "+v"(row));
                bf16x4 ga[4], gb[4];
#pragma unroll
                for (int bj = 0; bj < 2; ++bj)
#pragma unroll
                  for (int n = 0; n < 2; ++n) { const int col = bcol + bj * 128 + wc * 32 + n * 16 + fq * 4;
                    ga[bj * 2 + n] = ld4(U + (size_t)row * LDU + C_MRG + seg * 1024 + col); gb[bj * 2 + n] = ld4(U + (size_t)row * LDU + C_MRG + (seg + 1) * 1024 + col); }
#pragma unroll
                for (int bj = 0; bj < 2; ++bj)
#pragma unroll
                  for (int n = 0; n < 2; ++n)
#pragma unroll
                    for (int j = 0; j < 4; ++j) { const float za = bf2f((bf16_t)ga[bj * 2 + n][j]), zb = bf2f((bf16_t)gb[bj * 2 + n][j]);
                      acc[ai][bj][m][n][j] *= (1.f + __expf(fminf(-zb, 60.f))) * __builtin_amdgcn_rcpf(1.f + __expf(fminf(-za, 60.f))); }
                asm volatile("" ::: "memory"); }
          } else {
            EPI_LOOP( const bf16x4 gz = ld4(U + (size_t)row * LDU + C_MRG + 3 * 1024 + col); f32x4 r;
              for (int j = 0; j < 4; ++j) r[j] = v[j] * sigmoidf_(bf2f((bf16_t)gz[j]));
              *(bf16x4*)(H + (size_t)row * DM + col) = pack4(r); )
          } });
#endif
    }
    gsync(bar, epoch); if ((DUP >> 20) & 1) gsync(bar, epoch); TICK(6)
#ifndef NO_GEMM3
    gemm_stream(shm, DM, DM,
      [&](int i, GUnit& g) { const int u = blockIdx.x + i * (int)gridDim.x; if (u >= 64 * 4) return false; int pm, pn; tile_of(u, 64, 4, pm, pn);
        g.brow = pm * 256; g.bcol = pn * 256; g.nt = 16; g.aux = 0; g.keep = 0; g.cA = (const char*)(H + (size_t)g.brow * DM); g.cB = (const char*)(W + W_OUT + (size_t)g.bcol * DM); return true; },
      [&](const GUnit& g, f32x4 (&acc)[2][2][4][2]) { const int brow = g.brow, bcol = g.bcol;
        epi_loop2<2>(acc, brow, bcol,
          [&](int row, int col) -> f32x4 { return *(const f32x4*)(X + (size_t)row * DM + col); },
          [&](int row, int col, f32x4 v, f32x4 L) { const f32x4 gt = *(const f32x4*)(modl + (row >> 12) * 6144 + 2048 + col); *(f32x4*)(X + (size_t)row * DM + col) = L + gt * v; }); });
#endif
    gsync(bar, epoch); if ((DUP >> 20) & 1) gsync(bar, epoch); TICK(7)
    REP(8) {
#ifndef NO_NORM
    phase_norm(X, nullptr, p.in[5] + l * DM, modl, 3072, 4096, H);
#endif
    }
    gsync(bar, epoch); if ((DUP >> 20) & 1) gsync(bar, epoch); TICK(8)
    REP(9) {
#ifndef NO_GEMM4
      gemm_stream(shm, DM, DM,
        [&](int i, GUnit& g) { const int u = blockIdx.x + i * (int)gridDim.x; if (u >= 64 * 16) return false; int pm, pn; tile_of(u, 64, 16, pm, pn);
          g.brow = pm * 256; g.bcol = pn * 256; g.nt = 16; g.aux = 0; g.keep = 0; g.cA = (const char*)(H + (size_t)g.brow * DM); g.cB = (const char*)(W + W_FF1 + (size_t)g.bcol * DM); return true; },
        [&](const GUnit& g, f32x4 (&acc)[2][2][4][2]) { const int brow = g.brow, bcol = g.bcol;
          EPI_LOOP( f32x4 r; for (int j = 0; j < 4; ++j) { const float t = fmaxf(v[j], 0.f); r[j] = t * t; }
            *(bf16x4*)(HID + (size_t)row * DFF + col) = pack4(r); ) });
#endif
    }
    gsync(bar, epoch); if ((DUP >> 20) & 1) gsync(bar, epoch); TICK(9)
#ifndef NO_GEMM5
    gemm_stream(shm, DFF, DFF,
      [&](int i, GUnit& g) { const int u = blockIdx.x + i * (int)gridDim.x; if (u >= 64 * 4) return false; int pm, pn; tile_of(u, 64, 4, pm, pn);
        g.brow = pm * 256; g.bcol = pn * 256; g.nt = 64; g.aux = 0; g.keep = 0; g.cA = (const char*)(HID + (size_t)g.brow * DFF); g.cB = (const char*)(W + W_FF2 + (size_t)g.bcol * DFF); return true; },
      [&](const GUnit& g, f32x4 (&acc)[2][2][4][2]) { const int brow = g.brow, bcol = g.bcol;
        epi_loop2<2>(acc, brow, bcol,
          [&](int row, int col) -> f32x4 { return *(const f32x4*)(X + (size_t)row * DM + col); },
          [&](int row, int col, f32x4 v, f32x4 L) { const f32x4 gt = *(const f32x4*)(modl + (row >> 12) * 6144 + 5120 + col); *(f32x4*)(X + (size_t)row * DM + col) = L + gt * v; }); });
#endif
    gsync(bar, epoch); if ((DUP >> 20) & 1) gsync(bar, epoch); TICK(10)
  }
#ifndef NO_NORM
  phase_final_norm(X, p.in[28]);
#endif
#if DIAG
  if (blockIdx.x == 0 && threadIdx.x == 0) { bar[32] = accx_; bar[33] = accy_; }
  gsync(bar, epoch);
  { const float vx = (float)bar[32] * 0.01f, vy = (float)bar[33] * 0.01f;
    for (size_t i = (size_t)blockIdx.x * 512 + threadIdx.x; i < (size_t)NT * DM; i += (size_t)gridDim.x * 512) X[i] = vy;
    gsync(bar, epoch);
    if (blockIdx.x == 0 && threadIdx.x == 0) X[0] = 10.f * vx; }
#endif
}

extern "C" void kernel_launch(void* const* d_in, const int* in_sizes, int n_in, void* d_out, int out_size,
                              void* d_ws, size_t ws_size, hipStream_t stream) {
  constexpr size_t kDynLds = 136 * 1024;
  static int grid_blocks = 0;
  if (!grid_blocks) {
    int dev = 0, cus = 0, per_cu = 0;
    (void)hipGetDevice(&dev);
    (void)hipDeviceGetAttribute(&cus, hipDeviceAttributeMultiprocessorCount, dev);
    (void)hipFuncSetAttribute((const void*)mk, hipFuncAttributeMaxDynamicSharedMemorySize, (int)kDynLds);
    (void)hipOccupancyMaxActiveBlocksPerMultiprocessor(&per_cu, mk, 512, kDynLds);
    if (per_cu < 1) per_cu = 1;
    grid_blocks = cus;
  }
  Params p{};
  for (int i = 0; i < 29; ++i) p.in[i] = (const float*)d_in[i];
  p.X = (float*)d_out; p.ws = (char*)d_ws;
  (void)hipMemsetAsync(d_ws, 0, 16384, stream);
  void* args[] = {&p};
  hipError_t e = hipLaunchCooperativeKernel((void*)mk, dim3(grid_blocks), dim3(512), args, kDynLds, stream);
  if (e != hipSuccess) fprintf(stderr, "cooperative launch failed: %s (grid %d)\n", hipGetErrorString(e), grid_blocks);
}
```

```cpp
#include <hip/hip_runtime.h>
#include <hip/hip_cooperative_groups.h>
#include <cstdio>
#include <cstdint>
namespace cg = cooperative_groups;
#ifndef DIAG
#define DIAG 0
#endif
#ifndef DUP
#define DUP 0
#endif
#define REP(id) _Pragma("nounroll") for (int rep_ = 0; rep_ < 1 + ((DUP >> (id)) & 1); ++rep_)
#ifndef TX
#define TX 4
#endif
#ifndef TY
#define TY 12
#endif

#define DEVI __device__ __forceinline__
#define LAS __attribute__((address_space(3)))
#define LAUNDER(x) asm volatile("" : "+s"(x))
#define WSP char* ws_ = p.ws; LAUNDER(ws_)
#define TIDL int tid_ = threadIdx.x; asm volatile("" : "+v"(tid_))
typedef unsigned short bf16_t;
typedef short bf16x8 __attribute__((ext_vector_type(8)));
typedef short bf16x4 __attribute__((ext_vector_type(4)));
typedef float f32x4 __attribute__((ext_vector_type(4)));
typedef unsigned u32x4 __attribute__((ext_vector_type(4)));
typedef unsigned u32x2 __attribute__((ext_vector_type(2)));

constexpr int DM = 1024, NB = 4, SEQ = 4096, NT = NB * SEQ, NL = 4, NIN = 12320, LDU = 12544, DFF = 4096;
constexpr float EPS = 1e-6f;
constexpr int C_HGQ = 0, C_HGZF = 512, C_HGZB = 1024, C_HGI = 1536, C_HGG = 2048, C_NAQ = 2560, C_NAK = 3072, C_NAV = 3584,
              C_LRX = 4096, C_LRG = 4608, C_SSZ = 5120, C_SSX = 6144, C_SSB = 7168, C_SSC = 7680, C_SSDT = 8192, C_MRG = 8224;
constexpr int C_YHG = 0, C_OF = 512, C_OB = 1024, C_YNA = 1536, C_YLR = 4096, C_YSF = 6144, C_YSB = 7168, C_YSS = 3072, C_YD0 = 0, C_YD1 = 4096;

constexpr size_t MiB = 1048576;
constexpr size_t O_BAR = 0;
constexpr size_t O_MOD = 16384;
constexpr size_t O_LBV = O_MOD + 4 * 4 * 6144 * 4;
constexpr size_t O_W = 1 * MiB;
constexpr size_t W_IN = 0, W_BRHG = W_IN + (size_t)LDU * 1024, W_BRNA = W_BRHG + 1024 * 1024, W_BRLR = W_BRNA + 1024 * 1024,
                 W_BRSS = W_BRLR + 1024 * 1024, W_OUT = W_BRSS + 1024 * 1024, W_FF1 = W_OUT + 1024 * 1024, W_FF2 = W_FF1 + 4096 * 1024,
                 W_LRG = W_FF2 + 4096 * 1024, W_END = W_LRG + 32 * 4096;
constexpr size_t O_U = O_W + 51 * MiB;
constexpr size_t O_H = O_U + (size_t)NT * LDU * 2;
constexpr size_t O_QT = O_H + 32 * MiB;
constexpr size_t O_KC = O_QT + 32 * MiB;
constexpr size_t O_KT = O_KC + 32 * MiB;
constexpr size_t O_VT = O_KT + 32 * MiB;
constexpr size_t O_DEC = O_VT + 16 * MiB;
constexpr size_t O_VTN = O_DEC + 4 * MiB;
constexpr size_t O_HL = O_VTN + 16 * MiB;
constexpr size_t O_PP = O_HL + 32 * MiB;
constexpr size_t O_CP = O_PP + 32 * MiB;
constexpr size_t O_CH = O_CP + 1 * MiB;
constexpr size_t O_CIN = O_CH + 1 * MiB;
constexpr size_t O_XST = O_CIN + 1 * MiB;
constexpr size_t O_BM = O_XST + 32 * MiB;
constexpr size_t O_CM = O_BM + 16 * MiB;
constexpr size_t O_BT = O_CM + 16 * MiB;
constexpr size_t O_DT = O_BT + 16 * MiB;
constexpr size_t O_AA = O_DT + 2 * MiB;
constexpr size_t O_END = O_AA + 2 * MiB;
constexpr size_t O_MF32 = O_QT;
constexpr size_t O_HID = O_U;
static_assert(W_END * 2 <= 51 * MiB, "weights region");
static_assert(O_END <= 770 * MiB, "workspace");

struct Params {
  const float* in[29];
  float* X;
  char* ws;
};

DEVI float bf2f(bf16_t h) { return __uint_as_float((unsigned)h << 16); }
typedef float f32x2_ __attribute__((ext_vector_type(2)));
typedef __bf16 bf16v2_ __attribute__((ext_vector_type(2)));
DEVI unsigned cvt_pk_bf16(float lo, float hi) { const f32x2_ v = {lo, hi}; const bf16v2_ r = __builtin_convertvector(v, bf16v2_); return __builtin_bit_cast(unsigned, r); }
DEVI bf16_t f2bf(float f) { return (bf16_t)(cvt_pk_bf16(f, 0.f) & 0xffffu); }
DEVI float sigmoidf_(float x) { return __builtin_amdgcn_rcpf(1.f + __expf(-x)); }
DEVI float siluf_(float x) { return x * __builtin_amdgcn_rcpf(1.f + __expf(-x)); }
DEVI float softplusf_(float x) { return x > 20.f ? x : log1pf(__expf(x)); }
DEVI float gelu_tanh(float x) { float u = 0.7978845608028654f * (x + 0.044715f * x * x * x); float e = __expf(2.f * u); float th = 1.f - 2.f * __builtin_amdgcn_rcpf(e + 1.f); return 0.5f * x * (1.f + th); }
DEVI float wave_sum(float v) { for (int o = 32; o > 0; o >>= 1) v += __shfl_xor(v, o); return v; }
DEVI bf16x8 cat4(bf16x4 a, bf16x4 b) { return __builtin_shufflevector(a, b, 0, 1, 2, 3, 4, 5, 6, 7); }
DEVI bf16x4 pack4(f32x4 v) { u32x2 r; r.x = cvt_pk_bf16(v[0], v[1]); r.y = cvt_pk_bf16(v[2], v[3]); return __builtin_bit_cast(bf16x4, r); }
DEVI bf16x8 pack8(f32x4 a, f32x4 b) { u32x4 r; r.x = cvt_pk_bf16(a[0], a[1]); r.y = cvt_pk_bf16(a[2], a[3]); r.z = cvt_pk_bf16(b[0], b[1]); r.w = cvt_pk_bf16(b[2], b[3]); return __builtin_bit_cast(bf16x8, r); }
DEVI f32x4 mfma32(bf16x8 a, bf16x8 b, f32x4 c) { return __builtin_amdgcn_mfma_f32_16x16x32_bf16(a, b, c, 0, 0, 0); }
DEVI f32x4 mfma16(bf16x4 a, bf16x4 b, f32x4 c) { return __builtin_amdgcn_mfma_f32_16x16x16bf16_1k(a, b, c, 0, 0, 0); }
DEVI bf16x8 ld8(const bf16_t* p) { return *(const bf16x8*)p; }
DEVI bf16x4 ld4(const bf16_t* p) { return *(const bf16x4*)p; }

#define XB_TMO      128
#define XB_XCNT(j)  (256  + 64 * (j))
#define XB_XSUB(j)  (1280 + 64 * (j))
#define XB_XGEN(j)  (2304 + 64 * (j))
#define XB_TOP      3328
#define XB_TOPGEN   3392
#define XB_SPIN_CAP (1u << 22)
DEVI unsigned xb_ld(unsigned* p) { return __hip_atomic_load(p, __ATOMIC_RELAXED, __HIP_MEMORY_SCOPE_AGENT); }
DEVI unsigned xb_add(unsigned* p, unsigned v) { return __hip_atomic_fetch_add(p, v, __ATOMIC_RELAXED, __HIP_MEMORY_SCOPE_AGENT); }
DEVI unsigned xb_xcc_id() { return (unsigned)__builtin_amdgcn_s_getreg((3 << 11) | 20) & 0xFu; }
#define XB_SPIN(cond, bar) do { unsigned _sp = 0; while (cond) { __builtin_amdgcn_s_sleep(1); \
    if ((++_sp & 255u) == 0u) { if (xb_ld(&(bar)[XB_TMO])) break; if (_sp > XB_SPIN_CAP) { atomicAdd(&(bar)[XB_TMO], 1u); break; } } } } while (0)
struct XcdBarrier { unsigned* bar; unsigned x; volatile LAS unsigned* st; };
DEVI XcdBarrier xcd_barrier_post(unsigned* bar, volatile LAS unsigned* st) {
  XcdBarrier b; b.bar = bar; b.x = xb_xcc_id(); b.st = st;
  if (threadIdx.x == 0) (void)xb_add(&bar[XB_XCNT(b.x)], 1u);
  return b;
}
DEVI void xcd_barrier_complete(unsigned* bar, unsigned x, unsigned& nloc, unsigned& nx) {
  const unsigned G = gridDim.x; unsigned sum, cnt, mine, sp = 0u;
  for (;;) { sum = 0u; cnt = 0u; mine = 0u;
#pragma unroll
    for (unsigned j = 0; j < 16; ++j) { const unsigned c = xb_ld(&bar[XB_XCNT(j)]); sum += c; cnt += (c > 0u) ? 1u : 0u; mine = (j == x) ? c : mine; }
    if (sum == G) break;
    __builtin_amdgcn_s_sleep(1);
    if ((++sp & 255u) == 0u) { if (xb_ld(&bar[XB_TMO])) break; if (sp > XB_SPIN_CAP) { atomicAdd(&bar[XB_TMO], 1u); break; } } }
  nloc = mine > 0u ? mine : 1u; nx = cnt > 0u ? cnt : 1u;
}
DEVI void xcd_barrier(const XcdBarrier& b) {
  asm volatile("s_waitcnt vmcnt(0)" ::: "memory");
  __syncthreads();
  if (threadIdx.x == 0) {
    unsigned* bar = b.bar;
    __builtin_amdgcn_s_waitcnt(0);
    unsigned nloc = b.st[0], nx = b.st[1];
    if (nloc == 0u) { xcd_barrier_complete(bar, b.x, nloc, nx); b.st[0] = nloc; b.st[1] = nx; }
    const unsigned old = xb_add(&bar[XB_XSUB(b.x)], 1u);
    const unsigned gen = old / nloc;
    if (old + 1u == (gen + 1u) * nloc) {
      __builtin_amdgcn_fence(__ATOMIC_RELEASE, "agent");
      asm volatile("s_waitcnt vmcnt(0)" ::: "memory");
      const unsigned og = xb_add(&bar[XB_TOP], 1u);
      const unsigned tg = og / nx;
      if (og + 1u == (tg + 1u) * nx) xb_add(&bar[XB_TOPGEN], 1u);
      else XB_SPIN(xb_ld(&bar[XB_TOPGEN]) == tg, bar);
      __builtin_amdgcn_fence(__ATOMIC_ACQUIRE, "agent");
      xb_add(&bar[XB_XGEN(b.x)], 1u);
      asm volatile("s_waitcnt vmcnt(0)" ::: "memory");
    } else {
      XB_SPIN(xb_ld(&bar[XB_XGEN(b.x)]) == gen, bar);
      __builtin_amdgcn_fence(__ATOMIC_ACQUIRE, "agent");
      asm volatile("s_waitcnt vmcnt(0)" ::: "memory");
    }
  }
  __syncthreads();
}
#define gsync(bar_, epoch_) xcd_barrier(xb)

constexpr int HTB = 128 * 64 * 2;
DEVI int lds_byte(int r, int c) { int st = (r >> 4) * 2 + (c >> 5), rr = r & 15, cc = c & 31, ob = rr * 64 + cc * 2; return st * 1024 + (ob ^ (((ob >> 9) & 1) << 5)); }
DEVI void stage_rc(int b, int& R, int& C) { int st = b / 1024, sb = b % 1024, swz = sb ^ (((sb >> 9) & 1) << 5); R = (st >> 1) * 16 + swz / 64; C = (st & 1) * 32 + (swz % 64) / 2; }

#define SA(b, h) (((b) * 2 + (h)) * HTB)
#define SB(b, h) ((4 + (b) * 2 + (h)) * HTB)
#define STAGE(bufoff, gbase, voff) do { _Pragma("unroll") for (int _i = 0; _i < 2; ++_i) \
    __builtin_amdgcn_global_load_lds((const unsigned*)((const char*)(gbase) + (voff)[_i]), (LAS unsigned*)(shm + (bufoff) + ldsw + _i * 8192), 16, 0, 0); } while (0)
#define LDA(dst, b, h) do { _Pragma("unroll") for (int m = 0; m < 4; ++m) _Pragma("unroll") for (int k = 0; k < 2; ++k) dst[m][k] = *(const LAS bf16x8*)(shm + SA(b, h) + aoff + m * 2048 + k * 1024); } while (0)
#define LDB(dst, b, h) do { _Pragma("unroll") for (int n = 0; n < 2; ++n) _Pragma("unroll") for (int k = 0; k < 2; ++k) dst[n][k] = *(const LAS bf16x8*)(shm + SB(b, h) + boff + n * 2048 + k * 1024); } while (0)
#define MMA(ai, bj, At_, Bt_) do { __builtin_amdgcn_s_setprio(1); \
    _Pragma("unroll") for (int m = 0; m < 4; ++m) _Pragma("unroll") for (int n = 0; n < 2; ++n) _Pragma("unroll") for (int k = 0; k < 2; ++k) \
      acc[ai][bj][m][n] = __builtin_amdgcn_mfma_f32_16x16x32_bf16(Bt_[n][k], At_[m][k], acc[ai][bj][m][n], 0, 0, 0); \
    __builtin_amdgcn_s_setprio(0); } while (0)
#define WAIT_V(n) asm volatile("s_waitcnt vmcnt(" #n ")" ::: "memory")
#define WAIT_L(n) asm volatile("s_waitcnt lgkmcnt(" #n ")" ::: "memory")
#define BAR __builtin_amdgcn_s_barrier()
#define SCHED __builtin_amdgcn_sched_barrier(0)

DEVI void gemm_tile(const bf16_t* A, int lda, const bf16_t* Bt, int ldb, int K, int brow, int bcol, f32x4 (&acc)[2][2][4][2], LAS char* shm) {
  TIDL; const int tid = tid_, wid = __builtin_amdgcn_readfirstlane(tid >> 6), lane = tid & 63, wr = wid >> 2, wc = wid & 3, fr = lane & 15, fq = lane >> 4;
#pragma unroll
  for (int a = 0; a < 2; ++a)
#pragma unroll
    for (int b = 0; b < 2; ++b)
#pragma unroll
      for (int m = 0; m < 4; ++m)
#pragma unroll
        for (int n = 0; n < 2; ++n) acc[a][b][m][n] = (f32x4){0.f, 0.f, 0.f, 0.f};
  unsigned voffA[2], voffB[2];
#pragma unroll
  for (int i = 0; i < 2; ++i) { int R, C; stage_rc(tid * 16 + i * 8192, R, C); voffA[i] = (unsigned)(R * lda + C) * 2u; voffB[i] = (unsigned)(R * ldb + C) * 2u; }
  const size_t kstep = 128, hstepA = (size_t)128 * lda * 2, hstepB = (size_t)128 * ldb * 2;
  const unsigned ldsw = (unsigned)wid * 1024u;
  const int aoff = lds_byte(wr * 64 + fr, fq * 8), boff = lds_byte(wc * 32 + fr, fq * 8);
  const char* cA = (const char*)A + (size_t)brow * lda * 2; const char* cB = (const char*)Bt + (size_t)bcol * ldb * 2;
  bf16x8 At[4][2], B0[2][2], B1[2][2];
  const int nt = K / 64;
  STAGE(SB(0, 0), cB, voffB); STAGE(SA(0, 0), cA, voffA); STAGE(SB(0, 1), cB + hstepB, voffB); STAGE(SA(0, 1), cA + hstepA, voffA);
  if (wr == 1) BAR;
  WAIT_V(4); BAR;
  STAGE(SB(1, 0), cB + kstep, voffB); STAGE(SA(1, 0), cA + kstep, voffA); STAGE(SB(1, 1), cB + hstepB + kstep, voffB);
  WAIT_V(6); BAR;
  for (int t = 0; t < nt - 2; t += 2) {
    const char* a1 = cA + (size_t)(t + 1) * kstep; const char* a2 = cA + (size_t)(t + 2) * kstep; const char* b2 = cB + (size_t)(t + 2) * kstep;
    const char* a3 = a2 + kstep; const char* b3 = b2 + kstep;
    LDB(B0, 0, 0); SCHED; LDA(At, 0, 0); STAGE(SA(1, 1), a1 + hstepA, voffA);
    WAIT_L(8); BAR; WAIT_L(0); MMA(0, 0, At, B0); BAR; SCHED;
    LDB(B1, 0, 1); STAGE(SB(0, 0), b2, voffB);
    BAR; WAIT_L(0); MMA(0, 1, At, B1); BAR;
    LDA(At, 0, 1); STAGE(SA(0, 0), a2, voffA);
    BAR; WAIT_L(0); MMA(1, 0, At, B0); BAR; SCHED;
    STAGE(SB(0, 1), b2 + hstepB, voffB);
    WAIT_V(6); BAR; MMA(1, 1, At, B1); BAR;
    LDB(B0, 1, 0); SCHED; LDA(At, 1, 0); STAGE(SA(0, 1), a2 + hstepA, voffA);
    WAIT_L(8); BAR; WAIT_L(0); MMA(0, 0, At, B0); BAR; SCHED;
    LDB(B1, 1, 1); STAGE(SB(1, 0), b3, voffB);
    BAR; WAIT_L(0); MMA(0, 1, At, B1); BAR;
    LDA(At, 1, 1); STAGE(SA(1, 0), a3, voffA);
    BAR; WAIT_L(0); MMA(1, 0, At, B0); BAR; SCHED;
    STAGE(SB(1, 1), b3 + hstepB, voffB);
    WAIT_V(6); BAR; MMA(1, 1, At, B1); BAR;
  }
  { const char* a1 = cA + (size_t)(nt - 1) * kstep;
    LDB(B0, 0, 0); LDA(At, 0, 0); STAGE(SA(1, 1), a1 + hstepA, voffA);
    BAR; WAIT_L(0); MMA(0, 0, At, B0); BAR;
    LDB(B1, 0, 1); BAR; WAIT_L(0); MMA(0, 1, At, B1); BAR;
    LDA(At, 0, 1); WAIT_V(4); BAR; WAIT_L(0); MMA(1, 0, At, B0); MMA(1, 1, At, B1); BAR; }
  { LDB(B0, 1, 0); LDA(At, 1, 0); WAIT_V(2); BAR; WAIT_L(0); MMA(0, 0, At, B0); BAR;
    LDB(B1, 1, 1); WAIT_V(0); BAR; WAIT_L(0); MMA(0, 1, At, B1); BAR;
    LDA(At, 1, 1); BAR; WAIT_L(0); MMA(1, 0, At, B0); MMA(1, 1, At, B1); BAR; }
  if (wr == 0) BAR;
}

struct GUnit { const char* cA; const char* cB; int nt, brow, bcol, aux, keep; };
DEVI int perm32(int rho) { const int n = rho >> 4, i = rho & 15; return 8 * (i >> 2) + 4 * n + (i & 3); }
template <bool PERM, class UF, class EF>
DEVI void gemm_stream(LAS char* shm, int lda, int ldb, UF unit, EF epi) {
  TIDL; const int tid = tid_, wid = __builtin_amdgcn_readfirstlane(tid >> 6), lane = tid & 63, wr = wid >> 2, wc = wid & 3, fr = lane & 15, fq = lane >> 4;
  GUnit cur, nxt; int ui = 0;
  if (!unit(0, cur)) return;
  f32x4 acc[2][2][4][2];
#pragma unroll
  for (int a = 0; a < 2; ++a)
#pragma unroll
    for (int b = 0; b < 2; ++b)
#pragma unroll
      for (int m = 0; m < 4; ++m)
#pragma unroll
        for (int n = 0; n < 2; ++n) acc[a][b][m][n] = (f32x4){0.f, 0.f, 0.f, 0.f};
  unsigned voffA[2], voffB[2];
#pragma unroll
  for (int i = 0; i < 2; ++i) { int R, C; stage_rc(tid * 16 + i * 8192, R, C); const int Rb = PERM ? ((R & ~31) + perm32(R & 31)) : R; voffA[i] = (unsigned)(R * lda + C) * 2u; voffB[i] = (unsigned)(Rb * ldb + C) * 2u; }
  const size_t kstep = 128, hstepA = (size_t)128 * lda * 2, hstepB = (size_t)128 * ldb * 2;
  const unsigned ldsw = (unsigned)wid * 1024u;
  const int aoff = lds_byte(wr * 64 + fr, fq * 8), boff = lds_byte(wc * 32 + fr, fq * 8);
  bf16x8 At[4][2], B0[2][2], B1[2][2];
  { const char* cA = cur.cA; const char* cB = cur.cB;
    STAGE(SB(0, 0), cB, voffB); STAGE(SA(0, 0), cA, voffA); STAGE(SB(0, 1), cB + hstepB, voffB); STAGE(SA(0, 1), cA + hstepA, voffA);
    if (wr == 1) BAR;
    WAIT_V(4); BAR;
    STAGE(SB(1, 0), cB + kstep, voffB); STAGE(SA(1, 0), cA + kstep, voffA); STAGE(SB(1, 1), cB + hstepB + kstep, voffB);
    WAIT_V(6); BAR; }
  for (;;) {
    const bool has_next = unit(ui + 1, nxt);
    const char* cA = cur.cA; const char* cB = cur.cB;
    const char* nA = has_next ? nxt.cA : cA; const char* nB = has_next ? nxt.cB : cB;
    const int nt = cur.nt;
#pragma nounroll
    for (int t = 0; t < nt; t += 2) {
      const bool last = (t == nt - 2);
      const char* a1 = cA + (size_t)(t + 1) * kstep;
      const char* a2 = last ? nA : cA + (size_t)(t + 2) * kstep; const char* b2 = last ? nB : cB + (size_t)(t + 2) * kstep;
      const char* a3 = a2 + kstep; const char* b3 = b2 + kstep;
      LDB(B0, 0, 0); SCHED; LDA(At, 0, 0); STAGE(SA(1, 1), a1 + hstepA, voffA);
      WAIT_L(8); BAR; WAIT_L(0); MMA(0, 0, At, B0); BAR; SCHED;
      LDB(B1, 0, 1); STAGE(SB(0, 0), b2, voffB);
      BAR; WAIT_L(0); MMA(0, 1, At, B1); BAR;
      LDA(At, 0, 1); STAGE(SA(0, 0), a2, voffA);
      BAR; WAIT_L(0); MMA(1, 0, At, B0); BAR; SCHED;
      STAGE(SB(0, 1), b2 + hstepB, voffB);
      WAIT_V(6); BAR; MMA(1, 1, At, B1); BAR;
      LDB(B0, 1, 0); SCHED; LDA(At, 1, 0); STAGE(SA(0, 1), a2 + hstepA, voffA);
      WAIT_L(8); BAR; WAIT_L(0); MMA(0, 0, At, B0); BAR; SCHED;
      LDB(B1, 1, 1); STAGE(SB(1, 0), b3, voffB);
      BAR; WAIT_L(0); MMA(0, 1, At, B1); BAR;
      LDA(At, 1, 1); STAGE(SA(1, 0), a3, voffA);
      BAR; WAIT_L(0); MMA(1, 0, At, B0); BAR; SCHED;
      STAGE(SB(1, 1), b3 + hstepB, voffB);
      WAIT_V(6); BAR; MMA(1, 1, At, B1); BAR;
    }
    epi(cur, acc);
    if (!has_next) break;
    if (!cur.keep)
#pragma unroll
    for (int a = 0; a < 2; ++a)
#pragma unroll
      for (int b = 0; b < 2; ++b)
#pragma unroll
        for (int m = 0; m < 4; ++m)
#pragma unroll
          for (int n = 0; n < 2; ++n) acc[a][b][m][n] = (f32x4){0.f, 0.f, 0.f, 0.f};
    cur = nxt; ++ui;
  }
  WAIT_V(0);
  if (wr == 0) BAR;
  BAR;
}

DEVI void tile_of(int u, int nM, int nN, int& pm, int& pn) {
  const int nwg = nM * nN; int wgid = u;
  { const int q = nwg / 8, r = nwg % 8, xcd = wgid % 8, off = wgid / 8; wgid = (xcd < r ? xcd * (q + 1) : r * (q + 1) + (xcd - r) * q) + off; }
  const int nig = 8 * nN, gid = wgid / nig, fm = gid * 8, gsz = (nM - fm) < 8 ? (nM - fm) : 8;
  pm = fm + ((wgid % nig) % gsz); pn = (wgid % nig) / gsz;
}

template <int GM, class LF, class BF>
DEVI void epi_loop2(f32x4 (&acc)[2][2][4][2], int brow, int bcol, LF loadf, BF bodyf) {
  TIDL; const int wid = __builtin_amdgcn_readfirstlane(tid_ >> 6), lane = tid_ & 63, wr = wid >> 2, wc = wid & 3, fr = lane & 15, fq = lane >> 4;
#pragma unroll
  for (int ai = 0; ai < 2; ++ai)
#pragma unroll
    for (int mg = 0; mg < 4; mg += GM) {
      int rowb = brow + ai * 128 + wr * 64 + mg * 16 + fr; asm volatile("" : "+v"(rowb));
      f32x4 ld_[GM][4];
#pragma unroll
      for (int mm = 0; mm < GM; ++mm)
#pragma unroll
        for (int bj = 0; bj < 2; ++bj)
#pragma unroll
          for (int n = 0; n < 2; ++n) ld_[mm][bj * 2 + n] = loadf(rowb + mm * 16, bcol + bj * 128 + wc * 32 + n * 16 + fq * 4);
#pragma unroll
      for (int mm = 0; mm < GM; ++mm)
#pragma unroll
        for (int bj = 0; bj < 2; ++bj)
#pragma unroll
          for (int n = 0; n < 2; ++n) bodyf(rowb + mm * 16, bcol + bj * 128 + wc * 32 + n * 16 + fq * 4, acc[ai][bj][mg + mm][n], ld_[mm][bj * 2 + n]);
      asm volatile("" ::: "memory");
    }
}
#define EPI_PK(BODY) { TIDL; const int wid = __builtin_amdgcn_readfirstlane(tid_ >> 6), lane = tid_ & 63, wr = wid >> 2, wc = wid & 3, fr = lane & 15, fq = lane >> 4; \
  _Pragma("unroll") for (int ai = 0; ai < 2; ++ai) _Pragma("unroll") for (int m = 0; m < 4; ++m) { \
    int row = brow + ai * 128 + wr * 64 + m * 16 + fr; asm volatile("" : "+v"(row)); \
    _Pragma("unroll") for (int bj = 0; bj < 2; ++bj) { \
      const int col8 = bcol + bj * 128 + wc * 32 + fq * 8; const f32x4 v0 = acc[ai][bj][m][0], v1 = acc[ai][bj][m][1]; BODY } asm volatile("" ::: "memory"); } }
#define EPI_LOOP(BODY) { TIDL; const int wid = __builtin_amdgcn_readfirstlane(tid_ >> 6), lane = tid_ & 63, wr = wid >> 2, wc = wid & 3, fr = lane & 15, fq = lane >> 4; \
  _Pragma("unroll") for (int ai = 0; ai < 2; ++ai) _Pragma("unroll") for (int m = 0; m < 4; ++m) { \
    int row = brow + ai * 128 + wr * 64 + m * 16 + fr; asm volatile("" : "+v"(row)); \
    _Pragma("unroll") for (int bj = 0; bj < 2; ++bj) _Pragma("unroll") for (int n = 0; n < 2; ++n) { \
      const int col = bcol + bj * 128 + wc * 32 + n * 16 + fq * 4; f32x4 v = acc[ai][bj][m][n]; BODY } asm volatile("" ::: "memory"); } }

DEVI void phase_mod(const Params& p, char* smem) {
  TIDL;
  WSP;
  float* cs = (float*)smem; float* red = cs + 4096;
  const float* c = p.in[1]; const float* w_ada = p.in[2]; const float* b_ada = p.in[3];
  float* mod = (float*)(ws_ + O_MOD);
  for (int i = tid_; i < 4096; i += 512) cs[i] = siluf_(c[i]);
  __syncthreads();
  const int col = tid_ & 63, kg = tid_ >> 6;
  for (int it = blockIdx.x; it < 4 * 96; it += gridDim.x) {
    const int l = it / 96, cb = it % 96, j = cb * 64 + col;
    const float* w = w_ada + (size_t)l * 1024 * 6144 + j;
    float a0 = 0, a1 = 0, a2 = 0, a3 = 0;
#pragma unroll 8
    for (int k = kg * 128; k < kg * 128 + 128; ++k) { const float wv = w[(size_t)k * 6144]; a0 += cs[k] * wv; a1 += cs[1024 + k] * wv; a2 += cs[2048 + k] * wv; a3 += cs[3072 + k] * wv; }
    red[(kg * 64 + col) * 4 + 0] = a0; red[(kg * 64 + col) * 4 + 1] = a1; red[(kg * 64 + col) * 4 + 2] = a2; red[(kg * 64 + col) * 4 + 3] = a3;
    __syncthreads();
    if (tid_ < 256) { const int c2 = tid_ & 63, b = tid_ >> 6; float s = 0;
      for (int g = 0; g < 8; ++g) s += red[(g * 64 + c2) * 4 + b];
      mod[(l * 4 + b) * 6144 + cb * 64 + c2] = s + b_ada[l * 6144 + cb * 64 + c2]; }
    __syncthreads();
  }
  if (blockIdx.x == gridDim.x - 1) {
    const float* hg_lb = p.in[7]; float* lbv = (float*)(ws_ + O_LBV);
    for (int i = tid_; i < 1024; i += 512) { const int dir = i >> 9, k = i & 511;
      float v[4], mx = -1e30f; for (int l = 0; l < 4; ++l) { v[l] = hg_lb[(dir * 4 + l) * 512 + k]; mx = fmaxf(mx, v[l]); }
      float s = 0; for (int l = 0; l < 4; ++l) { v[l] = __expf(v[l] - mx); s += v[l]; }
      float cum = 0; lbv[(dir * 4 + 0) * 512 + k] = 0.f;
      for (int l = 1; l < 4; ++l) { cum += v[l]; lbv[(dir * 4 + l) * 512 + k] = cum / s; } }
  }
}

DEVI void tconv_batch4(const float* src, int K, int N, bf16_t* dst, int ldd, int ntn, int i0, float* tiles) {
  TIDL; const int tid = tid_;
  f32x4 v[4][2];
  const int kr = tid >> 4, nc = (tid & 15) * 4;
#pragma unroll
  for (int q = 0; q < 4; ++q) { const int k0 = ((i0 + q) / ntn) * 64, n0 = ((i0 + q) % ntn) * 64;
#pragma unroll
    for (int i = 0; i < 2; ++i) { const int k = kr + i * 32; v[q][i] = (f32x4){0.f, 0.f, 0.f, 0.f};
      if (n0 + nc < N) v[q][i] = *(const f32x4*)(src + (size_t)(k0 + k) * N + n0 + nc); } }
#pragma unroll
  for (int q = 0; q < 4; ++q) { float* tile = tiles + q * 4160;
#pragma unroll
    for (int i = 0; i < 2; ++i) { const int k = kr + i * 32;
      tile[k * 65 + nc + 0] = v[q][i][0]; tile[k * 65 + nc + 1] = v[q][i][1]; tile[k * 65 + nc + 2] = v[q][i][2]; tile[k * 65 + nc + 3] = v[q][i][3]; } }
  __syncthreads();
#pragma unroll
  for (int q = 0; q < 4; ++q) { const int k0 = ((i0 + q) / ntn) * 64, n0 = ((i0 + q) % ntn) * 64; const float* tile = tiles + q * 4160;
    const int n = tid >> 3, k8 = (tid & 7) * 8; u32x4 w;
    w.x = cvt_pk_bf16(tile[(k8 + 0) * 65 + n], tile[(k8 + 1) * 65 + n]); w.y = cvt_pk_bf16(tile[(k8 + 2) * 65 + n], tile[(k8 + 3) * 65 + n]);
    w.z = cvt_pk_bf16(tile[(k8 + 4) * 65 + n], tile[(k8 + 5) * 65 + n]); w.w = cvt_pk_bf16(tile[(k8 + 6) * 65 + n], tile[(k8 + 7) * 65 + n]);
    *(u32x4*)(dst + (size_t)(n0 + n) * ldd + k0 + k8) = w; }
  __syncthreads();
}
DEVI void phase_wconv(const Params& p, int l, char* smem) {
  WSP;
  float* tile = (float*)smem; bf16_t* W = (bf16_t*)(ws_ + O_W);
  for (int g = blockIdx.x; g < 6112 / 4; g += gridDim.x) {
    int i = g * 4;
    if (i < 3136) { tconv_batch4(p.in[6] + (size_t)l * 1024 * NIN, 1024, NIN, W + W_IN, 1024, 196, i, tile); continue; } i -= 3136;
    if (i < 128) { tconv_batch4(p.in[21] + (size_t)l * 512 * 1024, 512, 1024, W + W_BRHG, 1024, 16, i, tile); continue; } i -= 128;
    if (i < 128) { tconv_batch4(p.in[22] + (size_t)l * 512 * 1024, 512, 1024, W + W_BRNA, 1024, 16, i, tile); continue; } i -= 128;
    if (i < 128) { tconv_batch4(p.in[23] + (size_t)l * 512 * 1024, 512, 1024, W + W_BRLR, 1024, 16, i, tile); continue; } i -= 128;
    if (i < 256) { tconv_batch4(p.in[24] + (size_t)l * 1024 * 1024, 1024, 1024, W + W_BRSS, 1024, 16, i, tile); continue; } i -= 256;
    if (i < 256) { tconv_batch4(p.in[25] + (size_t)l * 1024 * 1024, 1024, 1024, W + W_OUT, 1024, 16, i, tile); continue; } i -= 256;
    if (i < 1024) { tconv_batch4(p.in[26] + (size_t)l * 1024 * 4096, 1024, 4096, W + W_FF1, 1024, 64, i, tile); continue; } i -= 1024;
    if (i < 1024) { tconv_batch4(p.in[27] + (size_t)l * 4096 * 1024, 4096, 1024, W + W_FF2, 4096, 16, i, tile); continue; } i -= 1024;
    tconv_batch4(p.in[12] + (size_t)l * 32 * 4096, 64 * 32, 64, W + W_LRG, 2048, 1, i, tile);
  }
}

DEVI void phase_norm(const float* src, float* xcopy, const float* g, const float* mod, int shift_off, int scale_off, bf16_t* H) {
  TIDL;
  const int wid = tid_ >> 6, lane = tid_ & 63;
  const int stride = gridDim.x * 8;
  for (int row = blockIdx.x * 8 + wid; row < NT; row += 2 * stride) {
    const int row2 = row + stride;
    const bool has2 = row2 < NT;
    f32x4 v[2][4]; float ss[2] = {0.f, 0.f};
#pragma unroll
    for (int rr = 0; rr < 2; ++rr)
#pragma unroll
      for (int i = 0; i < 4; ++i) { v[rr][i] = (rr == 0 || has2) ? *(const f32x4*)(src + (size_t)(rr ? row2 : row) * DM + i * 256 + lane * 4) : (f32x4){0.f, 0.f, 0.f, 0.f}; }
#pragma unroll
    for (int rr = 0; rr < 2; ++rr)
#pragma unroll
      for (int i = 0; i < 4; ++i) ss[rr] += v[rr][i][0] * v[rr][i][0] + v[rr][i][1] * v[rr][i][1] + v[rr][i][2] * v[rr][i][2] + v[rr][i][3] * v[rr][i][3];
    ss[0] = wave_sum(ss[0]); ss[1] = wave_sum(ss[1]);
#pragma unroll
    for (int rr = 0; rr < 2; ++rr) { if (rr == 1 && !has2) break;
      const int rw = rr ? row2 : row; const float r = rsqrtf(ss[rr] * (1.f / DM) + EPS);
      const float* mb = mod + (rw >> 12) * 6144;
#pragma unroll
      for (int i = 0; i < 4; ++i) { const int c = i * 256 + lane * 4;
        if (xcopy) *(f32x4*)(xcopy + (size_t)rw * DM + c) = v[rr][i];
        const f32x4 gg = *(const f32x4*)(g + c), sc = *(const f32x4*)(mb + scale_off + c), sh = *(const f32x4*)(mb + shift_off + c);
        f32x4 y; for (int j = 0; j < 4; ++j) y[j] = v[rr][i][j] * r * gg[j] * (1.f + sc[j]) + sh[j];
        *(bf16x4*)(H + (size_t)rw * DM + c) = pack4(y); } }
  }
}

DEVI void phase_final_norm(float* X, const float* g) {
  TIDL;
  const int wid = tid_ >> 6, lane = tid_ & 63;
  for (int row = blockIdx.x * 8 + wid; row < NT; row += gridDim.x * 8) {
    f32x4 v[4]; float ss = 0.f;
#pragma unroll
    for (int i = 0; i < 4; ++i) { v[i] = *(const f32x4*)(X + (size_t)row * DM + i * 256 + lane * 4); ss += v[i][0] * v[i][0] + v[i][1] * v[i][1] + v[i][2] * v[i][2] + v[i][3] * v[i][3]; }
    ss = wave_sum(ss); const float r = rsqrtf(ss * (1.f / DM) + EPS);
#pragma unroll
    for (int i = 0; i < 4; ++i) { const int c = i * 256 + lane * 4; const f32x4 gg = *(const f32x4*)(g + c);
      f32x4 y; for (int j = 0; j < 4; ++j) y[j] = v[i][j] * r * gg[j];
      *(f32x4*)(X + (size_t)row * DM + c) = y; }
  }
}

DEVI void phase_hg_pre(const Params& p, int l, char* smem) {
  WSP;
  TIDL;
  const bf16_t* U = (const bf16_t*)(ws_ + O_U);
  bf16_t* QT = (bf16_t*)(ws_ + O_QT); bf16_t* KC = (bf16_t*)(ws_ + O_KC); bf16_t* KT = (bf16_t*)(ws_ + O_KT); bf16_t* VT = (bf16_t*)(ws_ + O_VT);
  float* DEC = (float*)(ws_ + O_DEC); const float* lbv = (const float*)(ws_ + O_LBV);
  const int tid = tid_, h = tid >> 7, k = tid & 127;
  const float lb0 = lbv[(0 * 4 + l) * 512 + tid], lb1 = lbv[(1 * 4 + l) * 512 + tid];
  bf16_t* S = (bf16_t*)smem;
  for (int it = blockIdx.x; it < NB * 256; it += gridDim.x) {
    const int b = it >> 8, c = it & 255; const size_t row0 = (size_t)b * SEQ + c * 16;
#pragma unroll
    for (int i = 0; i < 8; ++i) { const int pz = tid + i * 512; const int r = pz >> 8, c8 = (pz & 255) * 8;
      *(u32x4*)(S + r * 2048 + c8) = *(const u32x4*)(U + (row0 + r) * LDU + C_HGQ + c8); }
    __syncthreads();
    float q[16], bc[16], kk[16];
#pragma unroll
    for (int t = 0; t < 16; ++t) q[t] = bf2f(S[t * 2048 + tid]);
    { unsigned vp[8];
#pragma unroll
      for (int t = 0; t < 16; t += 2) vp[t >> 1] = (unsigned)S[t * 2048 + 1536 + tid] | ((unsigned)S[(t + 1) * 2048 + 1536 + tid] << 16);
      bf16_t* d = VT + (((size_t)b * 4 + h) * 128 + k) * SEQ + c * 16;
      *(u32x4*)d = (u32x4){vp[0], vp[1], vp[2], vp[3]}; *(u32x4*)(d + 8) = (u32x4){vp[4], vp[5], vp[6], vp[7]}; }
    float zf[16], zb[16];
#pragma unroll
    for (int t = 0; t < 16; ++t) { zf[t] = bf2f(S[t * 2048 + 512 + tid]); zb[t] = bf2f(S[t * 2048 + 1024 + tid]); }
    __syncthreads();
#pragma unroll
    for (int dir = 0; dir < 2; ++dir) {
      const float lb = dir ? lb1 : lb0; float run = 0.f;
#pragma unroll
      for (int tt = 0; tt < 16; ++tt) { const int t = dir ? 15 - tt : tt;
        const float z = dir ? zb[t] : zf[t];
        float f = lb + (1.f - lb) * sigmoidf_(z); f = fmaxf(f, 1e-30f);
        run += __logf(f); bc[t] = run; kk[t] = 1.f - f; }
      const float tot = run;
      unsigned kp[8];
#pragma unroll
      for (int t = 0; t < 16; ++t) {
        S[((dir * 2 + 0) * 16 + t) * 512 + tid] = f2bf(q[t] * __expf(bc[t]));
        S[((dir * 2 + 1) * 16 + t) * 512 + tid] = f2bf(kk[t] * __expf(fminf(-bc[t], 80.f)));
      }
#pragma unroll
      for (int t = 0; t < 16; t += 2) kp[t >> 1] = cvt_pk_bf16(kk[t] * __expf(tot - bc[t]), kk[t + 1] * __expf(tot - bc[t + 1]));
      bf16_t* d = KT + ((((size_t)dir * NB + b) * 4 + h) * 128 + k) * SEQ + c * 16;
      *(u32x4*)d = (u32x4){kp[0], kp[1], kp[2], kp[3]}; *(u32x4*)(d + 8) = (u32x4){kp[4], kp[5], kp[6], kp[7]};
      DEC[(((size_t)dir * NB + b) * 256 + c) * 512 + tid] = __expf(tot);
    }
    __syncthreads();
#pragma unroll
    for (int i = 0; i < 8; ++i) { const int pz = tid + i * 512; const int arr = pz >> 10, r = (pz >> 6) & 15, c8 = (pz & 63) * 8;
      bf16_t* dst = ((arr & 1) ? KC : QT) + ((size_t)(arr >> 1) * NT + row0 + r) * 512 + c8;
      *(u32x4*)dst = *(const u32x4*)(S + (arr * 16 + r) * 512 + c8); }
    __syncthreads();
  }
}

DEVI void hg_scan_item(const Params& p, int item, char* smem) {
  WSP; TIDL;
  const int dir = item & 1, h = (item >> 1) & 3, b = item >> 3;
  const int w = __builtin_amdgcn_readfirstlane(tid_ >> 6), lane = tid_ & 63, fr = lane & 15, fq = lane >> 4;
  LAS char* shm = (LAS char*)smem;
  bf16_t* U = (bf16_t*)(ws_ + O_U);
  const char* QTb = (const char*)((const bf16_t*)(ws_ + O_QT) + ((size_t)dir * NT + (size_t)b * SEQ) * 512 + h * 128);
  const char* KCb = (const char*)((const bf16_t*)(ws_ + O_KC) + ((size_t)dir * NT + (size_t)b * SEQ) * 512 + h * 128);
  const char* KTb = (const char*)((const bf16_t*)(ws_ + O_KT) + (((size_t)dir * NB + b) * 4 + h) * 128 * SEQ);
  const char* VTb = (const char*)((const bf16_t*)(ws_ + O_VT) + ((size_t)b * 4 + h) * 128 * SEQ);
  const char* DECb = (const char*)((const float*)(ws_ + O_DEC) + ((size_t)dir * NB + b) * 256 * 512 + h * 128);
  const int P = (w & 3) * 64 + lane;
  const unsigned off0 = (unsigned)((P >> 4) * 1024 + (((P & 15) ^ (P >> 4)) * 16));
  const unsigned off1 = (unsigned)((P >> 1) * (SEQ * 2) + (P & 1) * 16);
  const char* g0 = (w < 4) ? QTb : KCb; const char* g1 = (w < 4) ? KTb : VTb;
  const unsigned l0 = ((w < 4) ? 0u : 4096u) + (unsigned)(w & 3) * 1024u, l1 = ((w < 4) ? 8192u : 12288u) + (unsigned)(w & 3) * 1024u;
  constexpr unsigned SLOT = 17408u;
#define HG_ISSUE(cc_, slot_) do { const int ci_ = (cc_) < 256 ? (cc_) : 255; const int c_ = dir ? 255 - ci_ : ci_; const unsigned so_ = (unsigned)(slot_) * SLOT; \
    __builtin_amdgcn_global_load_lds((const unsigned*)(g0 + (size_t)c_ * 16384 + off0), (LAS unsigned*)(shm + so_ + l0), 16, 0, 0); \
    __builtin_amdgcn_global_load_lds((const unsigned*)(g1 + (size_t)c_ * 32 + off1), (LAS unsigned*)(shm + so_ + l1), 16, 0, 0); \
    __builtin_amdgcn_global_load_lds((const unsigned*)(DECb + (size_t)c_ * 2048 + (lane & 31) * 16), (LAS unsigned*)(shm + so_ + 16384u), 16, 0, 0); } while (0)
  f32x4 st[8];
#pragma unroll
  for (int i = 0; i < 8; ++i) st[i] = (f32x4){0.f, 0.f, 0.f, 0.f};
  const int ocol = (dir ? C_OB : C_OF) + h * 128 + w * 16 + fq * 4;
  __builtin_amdgcn_s_barrier();
  for (int cc = 0; cc < 6; ++cc) HG_ISSUE(cc, cc);
  int s_cur = 0, s_iss = 6;
  const unsigned qo0 = (unsigned)(fr * 256 + (fq & 1) * 8);
#pragma nounroll
  for (int cc = 0; cc < 256; ++cc) {
    asm volatile("s_waitcnt vmcnt(15)" ::: "memory");
    __builtin_amdgcn_s_barrier();
    asm volatile("" ::: "memory");
    HG_ISSUE(cc + 6, s_iss); s_iss = (s_iss == 6) ? 0 : s_iss + 1;
    const int c = dir ? 255 - cc : cc; const size_t row0 = (size_t)b * SEQ + c * 16;
    const LAS char* sl = shm + (unsigned)s_cur * SLOT; s_cur = (s_cur == 6) ? 0 : s_cur + 1;
    bf16x8 qf[4], kf[4];
#pragma unroll
    for (int i2 = 0; i2 < 4; ++i2) {
      const unsigned pa = (unsigned)(((i2 * 4 + (fq >> 1)) ^ fr) * 16), pb = (unsigned)(((i2 * 4 + (fq >> 1) + 2) ^ fr) * 16);
      qf[i2] = cat4(*(const LAS bf16x4*)(sl + qo0 + pa), *(const LAS bf16x4*)(sl + qo0 + pb));
      kf[i2] = cat4(*(const LAS bf16x4*)(sl + 4096 + qo0 + pa), *(const LAS bf16x4*)(sl + 4096 + qo0 + pb)); }
    const bf16x4 vf = *(const LAS bf16x4*)(sl + 12288 + (w * 16 + fr) * 32 + fq * 8);
    bf16x4 ktf[8]; f32x4 dc[8];
#pragma unroll
    for (int kt = 0; kt < 8; ++kt) { ktf[kt] = *(const LAS bf16x4*)(sl + 8192 + (kt * 16 + fr) * 32 + fq * 8); dc[kt] = *(const LAS f32x4*)(sl + 16384 + (kt * 16 + fq * 4) * 4); }
    const f32x4 z4 = (f32x4){0.f, 0.f, 0.f, 0.f};
    f32x4 sca = mfma32(kf[0], qf[0], z4), scb = mfma32(kf[2], qf[2], z4);
    f32x4 oa = mfma32(pack8(st[0], st[1]), qf[0], z4), ob = mfma32(pack8(st[4], st[5]), qf[2], z4);
    sca = mfma32(kf[1], qf[1], sca); scb = mfma32(kf[3], qf[3], scb);
    oa = mfma32(pack8(st[2], st[3]), qf[1], oa); ob = mfma32(pack8(st[6], st[7]), qf[3], ob);
    f32x4 sc = sca + scb;
#pragma unroll
    for (int j = 0; j < 4; ++j) { const int s_ = fq * 4 + j, t = fr; const bool ok = dir ? (s_ >= t) : (s_ <= t); sc[j] = ok ? sc[j] : 0.f; }
    f32x4 o = mfma16(vf, pack4(sc), oa);
    o = o + ob;
    *(bf16x4*)(U + (row0 + fr) * LDU + ocol) = pack4(o);
#pragma unroll
    for (int kt = 0; kt < 8; ++kt) { st[kt] = st[kt] * dc[kt]; st[kt] = mfma16(ktf[kt], vf, st[kt]); }
  }
  asm volatile("s_waitcnt vmcnt(0)" ::: "memory");
  __syncthreads();
#undef HG_ISSUE
}

DEVI float one_minus_exp(float x) {
  return x > -0.05f ? -x * (1.f + x * (0.5f + x * (0.16666667f + x * 0.041666668f))) : 1.f - __expf(x);
}
DEVI void pre_tok64(const Params& p, int l, int item, char* smem) {
  WSP; TIDL;
  const int b = item >> 6, tile = item & 63; const int t0 = tile * 64; const size_t brow0 = (size_t)b * SEQ; const size_t row0 = brow0 + t0;
  const int tid = tid_, w = tid >> 6, lane = tid & 63, fr = lane & 15, fq = lane >> 4;
  const bf16_t* U = (const bf16_t*)(ws_ + O_U);
  bf16_t* S = (bf16_t*)smem;
  { const int t = tid >> 3, j4 = (tid & 7) * 4; const bf16x4 raw = ld4(U + (row0 + t) * LDU + C_SSDT + j4);
#pragma unroll
    for (int i = 0; i < 4; ++i) { const int cidx = j4 + i, dir = cidx >> 4, hh = cidx & 15;
      const float dt = softplusf_(bf2f((bf16_t)raw[i]) + p.in[17][(l * 2 + dir) * 16 + hh]);
      ((float*)(ws_ + O_DT))[((size_t)dir * NT + row0 + t) * 16 + hh] = dt;
      ((float*)(ws_ + O_AA))[((size_t)dir * NT + row0 + t) * 16 + hh] = -__expf(p.in[18][(l * 2 + dir) * 16 + hh]) * dt; } }
  u32x4 pre[9];
#define TOK_COL0(blk_) ((blk_) < 2 ? C_SSX + (blk_) * 512 : ((blk_) == 2 ? C_SSB : ((blk_) == 3 ? C_SSC : ((blk_) == 4 ? C_NAV : C_LRX))))
#define TOK_PREFETCH(blk_) do { const int col0_ = TOK_COL0(blk_); _Pragma("unroll") for (int it = 0; it < 9; ++it) { const int i = tid + it * 512; pre[it] = (u32x4){0u, 0u, 0u, 0u}; \
      if (i < 67 * 64) { const int r = i >> 6, c8 = (i & 63) * 8; const int tt = t0 - 2 + r; if (tt >= 0 && tt < SEQ) pre[it] = *(const u32x4*)(U + (brow0 + tt) * LDU + col0_ + c8); } } } while (0)
  TOK_PREFETCH(0);
#pragma nounroll
  for (int blk = 0; blk < 6; ++blk) {
#pragma unroll
    for (int it = 0; it < 9; ++it) { const int i = tid + it * 512; if (i < 67 * 64) { const int r = i >> 6, c8 = (i & 63) * 8; *(u32x4*)(S + r * 520 + c8) = pre[it]; } }
    __syncthreads();
    if (blk < 5) TOK_PREFETCH(blk + 1);
    float w0 = 0.f, w1 = 0.f, w2 = 1.f, w3 = 0.f, bias = 0.f;
    if (blk < 4) { const int ch = blk * 512 + tid; const float* cw = p.in[15] + (size_t)l * 4 * 2048; w0 = cw[ch]; w1 = cw[2048 + ch]; w2 = cw[4096 + ch]; w3 = cw[6144 + ch]; bias = p.in[16][(size_t)l * 2048 + ch]; }
    else if (blk == 5) { const float* cw = p.in[10] + (size_t)l * 4 * 512; w0 = cw[tid]; w1 = cw[512 + tid]; w2 = cw[1024 + tid]; w3 = cw[1536 + tid]; bias = p.in[11][l * 512 + tid]; }
    bf16_t* tdst = nullptr;
    if (blk < 2) { const int ch = blk * 512 + tid; tdst = (bf16_t*)(ws_ + O_XST) + (((size_t)b * 16 + (ch >> 6)) * 64 + (ch & 63)) * SEQ + t0; }
    else if (blk == 2) tdst = (bf16_t*)(ws_ + O_BT) + (((size_t)b * 4 + (tid >> 7)) * 128 + (tid & 127)) * SEQ + t0;
    else if (blk == 4) tdst = (bf16_t*)(ws_ + O_VTN) + (((size_t)b * 8 + (tid >> 6)) * 64 + (tid & 63)) * SEQ + t0;
    float xm2 = bf2f(S[0 * 520 + tid]), xm1 = bf2f(S[1 * 520 + tid]), x0 = bf2f(S[2 * 520 + tid]);
    for (int t8 = 0; t8 < 64; t8 += 8) { float y[8];
#pragma unroll
      for (int i = 0; i < 8; ++i) { const float x1 = bf2f(S[(t8 + i + 3) * 520 + tid]); float v = w0 * xm2 + w1 * xm1 + w2 * x0 + w3 * x1 + bias;
        if (blk < 4) v = siluf_(v);
        y[i] = v; xm2 = xm1; xm1 = x0; x0 = x1; }
      if (tdst) *(u32x4*)(tdst + t8) = (u32x4){cvt_pk_bf16(y[0], y[1]), cvt_pk_bf16(y[2], y[3]), cvt_pk_bf16(y[4], y[5]), cvt_pk_bf16(y[6], y[7])};
      if (blk == 2 || blk == 3 || blk == 5) {
#pragma unroll
        for (int i = 0; i < 8; ++i) S[(t8 + i) * 520 + tid] = f2bf(y[i]); }
    }
    __syncthreads();
    if (blk == 2 || blk == 3) {
      bf16_t* dst = (bf16_t*)(ws_ + (blk == 2 ? O_BM : O_CM));
#pragma unroll
      for (int it = 0; it < 8; ++it) { const int i = tid + it * 512; const int r = i >> 6, c8 = (i & 63) * 8;
        *(u32x4*)(dst + (row0 + r) * 512 + c8) = *(const u32x4*)(S + r * 520 + c8); }
      __syncthreads();
    }
  }
  { const bf16_t* xt = S;
    float* scr = (float*)(smem + 69888) + w * 2048;
    const bf16_t* WG = (const bf16_t*)(ws_ + O_W) + W_LRG;
    _Float16* HL = (_Float16*)(ws_ + O_HL); _Float16* PP = (_Float16*)(ws_ + O_PP);
    const int n = w;
    for (int dir = 0; dir < 2; ++dir) {
      bf16x8 wf[2][4][2];
#pragma unroll
      for (int g = 0; g < 2; ++g)
#pragma unroll
        for (int nt_ = 0; nt_ < 4; ++nt_)
#pragma unroll
          for (int ks = 0; ks < 2; ++ks) wf[g][nt_][ks] = ld8(WG + ((size_t)(nt_ * 16 + fr) * 32 + ((dir * 2 + g) * 8 + n)) * 64 + ks * 32 + fq * 8);
      float gbr[4], gbi[4], sp[4];
#pragma unroll
      for (int nt_ = 0; nt_ < 4; ++nt_) { const int ch = n * 64 + nt_ * 16 + fr;
        gbr[nt_] = p.in[13][((l * 2 + dir) * 2 + 0) * 512 + ch]; gbi[nt_] = p.in[13][((l * 2 + dir) * 2 + 1) * 512 + ch];
        sp[nt_] = softplusf_(-p.in[14][(l * 2 + dir) * 512 + ch]); }
      float hrun = 0.f, prun = 1.f;
      for (int mm = 0; mm < 4; ++mm) { const int mi = dir ? 3 - mm : mm;
        bf16x8 af[2];
#pragma unroll
        for (int ks = 0; ks < 2; ++ks) af[ks] = *(const bf16x8*)(xt + (mi * 16 + fr) * 520 + n * 64 + ks * 32 + fq * 8);
#pragma unroll
        for (int nt_ = 0; nt_ < 4; ++nt_) {
          f32x4 ar = (f32x4){0.f, 0.f, 0.f, 0.f}, ai_ = (f32x4){0.f, 0.f, 0.f, 0.f};
#pragma unroll
          for (int ks = 0; ks < 2; ++ks) { ar = mfma32(af[ks], wf[0][nt_][ks], ar); ai_ = mfma32(af[ks], wf[1][nt_][ks], ai_); }
#pragma unroll
          for (int j = 0; j < 4; ++j) { const int tl = fq * 4 + j, e = nt_ * 16 + fr;
            const float xv = bf2f(xt[(mi * 16 + tl) * 520 + n * 64 + e]);
            const float rg = sigmoidf_(ar[j] + gbr[nt_]), ig = sigmoidf_(ai_[j] + gbi[nt_]);
            const float la = -8.f * rg * sp[nt_]; const float a = __expf(la);
            const float mult = __builtin_amdgcn_sqrtf(fmaxf(one_minus_exp(2.f * la), 0.f));
            scr[tl * 64 + e] = a; scr[1024 + tl * 64 + e] = mult * ig * xv; }
        }
        __builtin_amdgcn_wave_barrier(); asm volatile("s_waitcnt lgkmcnt(0)" ::: "memory");
        for (int t2 = 0; t2 < 16; ++t2) { const int tl = dir ? 15 - t2 : t2;
          const float a = scr[tl * 64 + lane], u = scr[1024 + tl * 64 + lane];
          hrun = a * hrun + u; prun *= a;
          const size_t o = ((size_t)dir * NT + row0 + mi * 16 + tl) * 512 + n * 64 + lane;
          HL[o] = (_Float16)hrun; PP[o] = (_Float16)prun; }
        __builtin_amdgcn_wave_barrier(); asm volatile("s_waitcnt lgkmcnt(0)" ::: "memory");
      }
      const size_t co = (((size_t)dir * NB + b) * 64 + tile) * 512 + n * 64 + lane;
      ((float*)(ws_ + O_CP))[co] = prun; ((float*)(ws_ + O_CH))[co] = hrun;
    }
    __syncthreads();
  }
}

DEVI void lru_carry_item(const Params& p, int item) {
  TIDL;
  WSP;
  const int g = item * 512 + tid_; const int dir = g >> 11, b = (g >> 9) & 3, ch = g & 511;
  const float* CP = (const float*)(ws_ + O_CP); const float* CH = (const float*)(ws_ + O_CH); float* CIN = (float*)(ws_ + O_CIN);
  float run = 0.f;
  for (int i = 0; i < 64; ++i) { const int tile = dir ? 63 - i : i; const size_t o = (((size_t)dir * NB + b) * 64 + tile) * 512 + ch;
    CIN[o] = run; run = CP[o] * run + CH[o]; }
}

DEVI void ssd_diag_item(const Params& p, int l, int item, char* smem) {
  TIDL;
  WSP;
  const int n = item & 31, g = (item >> 5) & 3, b = item >> 7;
  const int tid = tid_, w = tid >> 6, lane = tid & 63, fr = lane & 15, fq = lane >> 4;
  bf16_t* U = (bf16_t*)(ws_ + O_U);
  const bf16_t* BM = (const bf16_t*)(ws_ + O_BM) + g * 128; const bf16_t* CM = (const bf16_t*)(ws_ + O_CM) + g * 128;
  float* acum = (float*)smem;
  float* dtv = acum + 1024;
  const size_t row0 = (size_t)b * SEQ + n * 128; const int tc0 = n * 128;
  {
    const int dir = w & 1, hh = g * 4 + (w >> 1);
    const float* DT = (const float*)(ws_ + O_DT) + (size_t)dir * NT * 16 + hh; const float* AA = (const float*)(ws_ + O_AA) + (size_t)dir * NT * 16 + hh;
    const float a0 = AA[(row0 + 2 * lane) * 16], a1 = AA[(row0 + 2 * lane + 1) * 16];
    const float d0 = DT[(row0 + 2 * lane) * 16], d1 = DT[(row0 + 2 * lane + 1) * 16];
    float s_ = a0 + a1, inc = s_;
    for (int o = 1; o < 64; o <<= 1) { const float t = __shfl_up(inc, o); if (lane >= o) inc += t; }
    const float total = __shfl(inc, 63); const float exc = inc - s_;
    float c0, c1;
    if (!dir) { c0 = exc + a0; c1 = exc + a0 + a1; } else { c0 = total - exc; c1 = total - exc - a0; }
    acum[w * 128 + 2 * lane] = c0 * 1.4426950408889634f; acum[w * 128 + 2 * lane + 1] = c1 * 1.4426950408889634f;
    dtv[w * 128 + 2 * lane] = d0; dtv[w * 128 + 2 * lane + 1] = d1;
  }
  int q = w * 16 + fr; asm volatile("" : "+v"(q));
  f32x4 cb[8];
  { bf16x8 cf[4];
#pragma unroll
    for (int ks = 0; ks < 4; ++ks) cf[ks] = ld8(CM + (row0 + q) * 512 + ks * 32 + fq * 8);
#pragma unroll
    for (int kt = 0; kt < 8; ++kt) { cb[kt] = (f32x4){0.f, 0.f, 0.f, 0.f};
#pragma unroll
      for (int ks = 0; ks < 4; ++ks) cb[kt] = mfma32(ld8(BM + (row0 + kt * 16 + fr) * 512 + ks * 32 + fq * 8), cf[ks], cb[kt]); } }
  __syncthreads();
#pragma nounroll
  for (int r = 0; r < 4; ++r) {
    const int hh = g * 4 + r;
    const bf16_t* XST = (const bf16_t*)(ws_ + O_XST) + ((size_t)b * 16 + hh) * 64 * SEQ;
    const float skip = p.in[19][l * 16 + hh];
    const float* acf = acum + (r * 2) * 128; const float* acb = acf + 128; const float* dtf = dtv + (r * 2) * 128; const float* dtb = dtf + 128;
    const float aqf = acf[q], aqb = acb[q];
    f32x4 y[4];
#pragma unroll
    for (int pt = 0; pt < 4; ++pt) y[pt] = (f32x4){0.f, 0.f, 0.f, 0.f};
#pragma unroll
    for (int c2 = 0; c2 < 4; ++c2) {
      f32x4 mt[2];
#pragma unroll
      for (int hf = 0; hf < 2; ++hf) { const int kt = 2 * c2 + hf; const int kb = kt * 16 + fq * 4;
        const f32x4 af = *(const f32x4*)(acf + kb), ab = *(const f32x4*)(acb + kb), df = *(const f32x4*)(dtf + kb), db = *(const f32x4*)(dtb + kb);
#pragma unroll
        for (int j = 0; j < 4; ++j) { const int k = kb + j; const bool lo = k < q;
          const float arg = lo ? (aqf - af[j]) : (aqb - ab[j]);
          float wgt_ = __builtin_amdgcn_exp2f(arg) * (lo ? df[j] : db[j]);
          wgt_ += (k == q) ? df[j] : 0.f;
          mt[hf][j] = cb[kt][j] * wgt_; } }
      const bf16x8 mf = pack8(mt[0], mt[1]);
#pragma unroll
      for (int pt = 0; pt < 4; ++pt) { const bf16_t* xp = XST + (size_t)(pt * 16 + fr) * SEQ + tc0 + c2 * 32 + fq * 4;
        y[pt] = mfma32(cat4(ld4(xp), ld4(xp + 16)), mf, y[pt]); }
    }
    const int ycol = (hh < 8 ? C_YD0 : C_YD1) + (hh & 7) * 64;
#pragma unroll
    for (int pt = 0; pt < 4; ++pt) { f32x4 v = y[pt];
#pragma unroll
      for (int j = 0; j < 4; ++j) v[j] += skip * bf2f(XST[(size_t)(pt * 16 + fq * 4 + j) * SEQ + tc0 + q]);
      *(bf16x4*)(U + (row0 + q) * LDU + ycol + pt * 16 + fq * 4) = pack4(v); }
  }
  __syncthreads();
}

DEVI void ssd_scan_item(const Params& p, int l, int item, char* smem) {
  TIDL;
  WSP;
  const int dir = item & 1, hh = (item >> 1) & 15, b = item >> 5, g = hh >> 2;
  const int tid = tid_, w = tid >> 6, lane = tid & 63, fr = lane & 15, fq = lane >> 4;
  bf16_t* U = (bf16_t*)(ws_ + O_U);
  const bf16_t* XST = (const bf16_t*)(ws_ + O_XST) + ((size_t)b * 16 + hh) * 64 * SEQ;
  const bf16_t* CM = (const bf16_t*)(ws_ + O_CM) + g * 128;
  const bf16_t* BT = (const bf16_t*)(ws_ + O_BT) + ((size_t)b * 4 + g) * 128 * SEQ;
  const float* DT = (const float*)(ws_ + O_DT) + (size_t)dir * NT * 16 + hh; const float* AA = (const float*)(ws_ + O_AA) + (size_t)dir * NT * 16 + hh;
  float* acum = (float*)smem;
  float* wgt = acum + 256;
  float* tot = wgt + 256;
  bf16_t* stl = (bf16_t*)(smem + 4096);
  for (int i = tid; i < 64 * 136; i += 512) stl[i] = 0;
  f32x4 stT[4];
#pragma unroll
  for (int i = 0; i < 4; ++i) stT[i] = (f32x4){0.f, 0.f, 0.f, 0.f};
  const int q = w * 16 + fr;
  bf16x8 cf[4]; float a0 = 0.f, a1 = 0.f, d0 = 0.f, d1 = 0.f;
#define SSD_LOADC(nn_, CF, A0, A1, D0, D1) do { const int n_ = dir ? 31 - (nn_) : (nn_); const size_t r0_ = (size_t)b * SEQ + n_ * 128; \
    _Pragma("unroll") for (int ks = 0; ks < 4; ++ks) CF[ks] = ld8(CM + (r0_ + q) * 512 + ks * 32 + fq * 8); \
    if (w == 0) { A0 = AA[(r0_ + 2 * lane) * 16]; A1 = AA[(r0_ + 2 * lane + 1) * 16]; D0 = DT[(r0_ + 2 * lane) * 16]; D1 = DT[(r0_ + 2 * lane + 1) * 16]; } } while (0)
  SSD_LOADC(0, cf, a0, a1, d0, d1);
#pragma nounroll
  for (int nn = 0; nn < 32; ++nn) {
    const int n = dir ? 31 - nn : nn, par = nn & 1; const size_t row0 = (size_t)b * SEQ + n * 128; const int tc0 = n * 128;
    bf16x8 br[4], xs[4][4];
#pragma unroll
    for (int ks = 0; ks < 4; ++ks) { br[ks] = ld8(BT + (size_t)(w * 16 + fr) * SEQ + tc0 + ks * 32 + fq * 8);
#pragma unroll
      for (int pt = 0; pt < 4; ++pt) xs[ks][pt] = ld8(XST + (size_t)(pt * 16 + fr) * SEQ + tc0 + ks * 32 + fq * 8); }
    bf16x8 cfn[4]; float a0n = 0.f, a1n = 0.f, d0n = 0.f, d1n = 0.f;
    { const int nx = nn < 31 ? nn + 1 : 31; SSD_LOADC(nx, cfn, a0n, a1n, d0n, d1n); }
    if (w == 0) {
      float s_ = a0 + a1, inc = s_;
      for (int o = 1; o < 64; o <<= 1) { const float t = __shfl_up(inc, o); if (lane >= o) inc += t; }
      const float total = __shfl(inc, 63); const float exc = inc - s_;
      float c0, c1;
      if (!dir) { c0 = exc + a0; c1 = exc + a0 + a1; } else { c0 = total - exc; c1 = total - exc - a0; }
      acum[par * 128 + 2 * lane] = c0; acum[par * 128 + 2 * lane + 1] = c1;
      wgt[par * 128 + 2 * lane] = __expf(total - c0) * d0; wgt[par * 128 + 2 * lane + 1] = __expf(total - c1) * d1;
      if (lane == 0) tot[par] = total;
    }
    __syncthreads();
    const float* ac = acum + par * 128; const float* wg = wgt + par * 128;
    const float acq = ac[q];
    f32x4 y[4];
#pragma unroll
    for (int pt = 0; pt < 4; ++pt) { y[pt] = (f32x4){0.f, 0.f, 0.f, 0.f};
#pragma unroll
      for (int ks = 0; ks < 4; ++ks) y[pt] = mfma32(*(const bf16x8*)(stl + (pt * 16 + fr) * 136 + ks * 32 + fq * 8), cf[ks], y[pt]); }
    const float eq = __expf(acq);
#pragma unroll
    for (int pt = 0; pt < 4; ++pt) *(bf16x4*)(U + (row0 + q) * LDU + (dir ? C_YSB : C_YSF) + hh * 64 + pt * 16 + fq * 4) = pack4(y[pt] * eq);
    const float et = __expf(tot[par]);
#pragma unroll
    for (int pt = 0; pt < 4; ++pt) stT[pt] = stT[pt] * et;
#pragma unroll
    for (int ks = 0; ks < 4; ++ks) {
      f32x4 lo, hi;
#pragma unroll
      for (int i = 0; i < 4; ++i) { lo[i] = bf2f((bf16_t)br[ks][i]) * wg[ks * 32 + fq * 8 + i]; hi[i] = bf2f((bf16_t)br[ks][4 + i]) * wg[ks * 32 + fq * 8 + 4 + i]; }
      const bf16x8 bw = pack8(lo, hi);
#pragma unroll
      for (int pt = 0; pt < 4; ++pt) stT[pt] = mfma32(bw, xs[ks][pt], stT[pt]);
    }
    __syncthreads();
#pragma unroll
    for (int pt = 0; pt < 4; ++pt) *(bf16x4*)(stl + (pt * 16 + fr) * 136 + w * 16 + fq * 4) = pack4(stT[pt]);
#pragma unroll
    for (int ks = 0; ks < 4; ++ks) cf[ks] = cfn[ks];
    a0 = a0n; a1 = a1n; d0 = d0n; d1 = d1n;
  }
#undef SSD_LOADC
  __syncthreads();
}

DEVI void na_item(const Params& p, int l, int item, const char* smem) {
  TIDL;
  WSP;
  const int w = tid_ >> 6, lane = tid_ & 63, fr = lane & 15, fq = lane >> 4;
  const int m = item & 3, r = (item >> 2) & 63, b = item >> 8, hd = w;
  bf16_t* U = (bf16_t*)(ws_ + O_U);
  const bf16_t* VTN = (const bf16_t*)(ws_ + O_VTN) + ((size_t)b * 8 + hd) * 64 * SEQ;
  const float* rpb = (const float*)(smem + 16384) + hd * 465;
  int kr0 = r - 4; kr0 = kr0 < 0 ? 0 : (kr0 > 56 ? 56 : kr0);
  int kc0 = m * 16 - 8; kc0 = kc0 < 0 ? 0 : (kc0 > 32 ? 32 : kc0);
  const size_t qrow = (size_t)b * SEQ + r * 64 + m * 16 + fr;
  bf16x8 qf[2];
#pragma unroll
  for (int ks = 0; ks < 2; ++ks) qf[ks] = ld8(U + qrow * LDU + C_NAQ + hd * 64 + ks * 32 + fq * 8);
  const int qcol = m * 16 + fr; int cst = qcol - 8; cst = cst < 0 ? 0 : (cst > 48 ? 48 : cst);
  f32x4 s[16]; float mx = -1e30f;
#pragma unroll
  for (int a = 0; a < 8; ++a)
#pragma unroll
    for (int hf = 0; hf < 2; ++hf) { const int ti = a * 2 + hf;
      const size_t krow = (size_t)b * SEQ + (kr0 + a) * 64 + kc0 + hf * 16 + fr;
      f32x4 acc = (f32x4){0.f, 0.f, 0.f, 0.f};
#pragma unroll
      for (int ks = 0; ks < 2; ++ks) acc = mfma32(ld8(U + krow * LDU + C_NAK + hd * 64 + ks * 32 + fq * 8), qf[ks], acc);
      const int dr = kr0 + a - r + 7;
#pragma unroll
      for (int j = 0; j < 4; ++j) { const int kcol = kc0 + hf * 16 + fq * 4 + j; const bool ok = (kcol >= cst) && (kcol < cst + 16);
        int dcc = kcol - qcol; dcc = dcc < -15 ? -15 : (dcc > 15 ? 15 : dcc);
        const float v = ok ? acc[j] * 0.125f + rpb[dr * 31 + dcc + 15] : -1e30f; acc[j] = v; mx = fmaxf(mx, v); }
      s[ti] = acc; }
  mx = fmaxf(mx, __shfl_xor(mx, 16)); mx = fmaxf(mx, __shfl_xor(mx, 32));
  float sum = 0.f;
#pragma unroll
  for (int ti = 0; ti < 16; ++ti)
#pragma unroll
    for (int j = 0; j < 4; ++j) { const float e = s[ti][j] > -1e29f ? __expf(s[ti][j] - mx) : 0.f; s[ti][j] = e; sum += e; }
  sum += __shfl_xor(sum, 16); sum += __shfl_xor(sum, 32);
  const float inv = __builtin_amdgcn_rcpf(sum);
  f32x4 o[4];
#pragma unroll
  for (int dt = 0; dt < 4; ++dt) o[dt] = (f32x4){0.f, 0.f, 0.f, 0.f};
#pragma unroll
  for (int a = 0; a < 8; ++a) { const bf16x8 pf = pack8(s[2 * a], s[2 * a + 1]);
#pragma unroll
    for (int dt = 0; dt < 4; ++dt) { const bf16_t* vp = VTN + (size_t)(dt * 16 + fr) * SEQ + (kr0 + a) * 64 + kc0 + fq * 4;
      o[dt] = mfma32(cat4(ld4(vp), ld4(vp + 16)), pf, o[dt]); } }
#pragma unroll
  for (int dt = 0; dt < 4; ++dt) *(bf16x4*)(U + qrow * LDU + C_YNA + hd * 64 + dt * 16 + fq * 4) = pack4(o[dt] * inv);
}

DEVI void phase_finalize(const Params& p, int l) {
  TIDL;
  WSP;
  const int wid = tid_ >> 6, lane = tid_ & 63;
  bf16_t* U = (bf16_t*)(ws_ + O_U);
  const _Float16* HL = (const _Float16*)(ws_ + O_HL); const _Float16* PP = (const _Float16*)(ws_ + O_PP); const float* CIN = (const float*)(ws_ + O_CIN);
  const float* hgn = p.in[8] + l * 512; const float* ssn = p.in[20] + l * 1024;
  for (int row = blockIdx.x * 8 + wid; row < NT; row += gridDim.x * 8) {
    bf16_t* ur = U + (size_t)row * LDU; const int b = row >> 12, tile = (row & 4095) >> 6;
    {
      const int c = lane * 16; float y[16], ss = 0.f;
#pragma unroll
      for (int hf = 0; hf < 2; ++hf) { const bf16x8 yf = ld8(ur + C_YSF + c + hf * 8), yb = ld8(ur + C_YSB + c + hf * 8), zz = ld8(ur + C_SSZ + c + hf * 8), yd = ld8(ur + (c < 512 ? C_YD0 + c : C_YD1 + c - 512) + hf * 8);
#pragma unroll
        for (int i = 0; i < 8; ++i) { const float v = (bf2f((bf16_t)yf[i]) + bf2f((bf16_t)yb[i]) + bf2f((bf16_t)yd[i])) * siluf_(bf2f((bf16_t)zz[i])); y[hf * 8 + i] = v; ss += v * v; } }
      ss = wave_sum(ss); const float r = rsqrtf(ss * (1.f / 1024.f) + EPS);
#pragma unroll
      for (int hf = 0; hf < 2; ++hf) { float t[8];
#pragma unroll
        for (int i = 0; i < 8; ++i) t[i] = y[hf * 8 + i] * r * ssn[c + hf * 8 + i];
        *(u32x4*)(ur + C_YSS + c + hf * 8) = (u32x4){cvt_pk_bf16(t[0], t[1]), cvt_pk_bf16(t[2], t[3]), cvt_pk_bf16(t[4], t[5]), cvt_pk_bf16(t[6], t[7])}; } }
    {
      const int c = lane * 8; const bf16x8 of = ld8(ur + C_OF + c), ob = ld8(ur + C_OB + c), gg = ld8(ur + C_HGG + c);
      float o[8], ss = 0.f;
#pragma unroll
      for (int i = 0; i < 8; ++i) { o[i] = bf2f((bf16_t)of[i]) + bf2f((bf16_t)ob[i]); ss += o[i] * o[i]; }
      ss += __shfl_xor(ss, 1); ss += __shfl_xor(ss, 2); ss += __shfl_xor(ss, 4); ss += __shfl_xor(ss, 8);
      const float r = rsqrtf(ss * (1.f / 128.f) + EPS); float y[8];
#pragma unroll
      for (int i = 0; i < 8; ++i) y[i] = o[i] * r * hgn[c + i] * siluf_(bf2f((bf16_t)gg[i]));
      *(u32x4*)(ur + C_YHG + c) = (u32x4){cvt_pk_bf16(y[0], y[1]), cvt_pk_bf16(y[2], y[3]), cvt_pk_bf16(y[4], y[5]), cvt_pk_bf16(y[6], y[7])}; }
    {
      typedef _Float16 h8 __attribute__((ext_vector_type(8)));
      const int c = lane * 8; const bf16x8 gg = ld8(ur + C_LRG + c); float y[8];
      float hs[8] = {0.f, 0.f, 0.f, 0.f, 0.f, 0.f, 0.f, 0.f};
#pragma unroll
      for (int dir = 0; dir < 2; ++dir) { const size_t o = ((size_t)dir * NT + row) * 512 + c;
        const h8 hl = *(const h8*)(HL + o), pp = *(const h8*)(PP + o);
        const float* ci = CIN + (((size_t)dir * NB + b) * 64 + tile) * 512 + c; const f32x4 c0 = *(const f32x4*)ci, c1 = *(const f32x4*)(ci + 4);
#pragma unroll
        for (int i = 0; i < 8; ++i) hs[i] += (float)hl[i] + (float)pp[i] * (i < 4 ? c0[i] : c1[i - 4]); }
#pragma unroll
      for (int i = 0; i < 8; ++i) y[i] = hs[i] * gelu_tanh(bf2f((bf16_t)gg[i]));
      *(u32x4*)(ur + C_YLR + c) = (u32x4){cvt_pk_bf16(y[0], y[1]), cvt_pk_bf16(y[2], y[3]), cvt_pk_bf16(y[4], y[5]), cvt_pk_bf16(y[6], y[7])}; }
  }
}

__global__ void __launch_bounds__(512) mk(Params p) {
  cg::grid_group grid = cg::this_grid();
  extern __shared__ __attribute__((aligned(16))) char smem[];
  LAS char* shm = (LAS char*)smem;
  volatile int& s_item = *(volatile int*)(smem + 139264 - 16);
  unsigned* bar = (unsigned*)(p.ws + O_BAR); unsigned epoch = 0; (void)epoch;
  volatile LAS unsigned* xst = (volatile LAS unsigned*)(shm + 139264 - 32);
  if (threadIdx.x == 0) { xst[0] = 0u; xst[1] = 0u; }
  __syncthreads();
  const XcdBarrier xb = xcd_barrier_post(bar, xst);
#if DIAG
  unsigned long long tprev_ = wall_clock64(); unsigned accx_ = 0, accy_ = 0;
#define TICK(i) { const unsigned long long now_ = wall_clock64(); const unsigned d_ = (unsigned)(now_ - tprev_); tprev_ = now_; if ((i) == TX) accx_ += d_; if ((i) == TY) accy_ += d_; }
#else
#define TICK(i)
#endif
  bf16_t* U = (bf16_t*)(p.ws + O_U); bf16_t* H = (bf16_t*)(p.ws + O_H); bf16_t* W = (bf16_t*)(p.ws + O_W);
  float* MF = (float*)(p.ws + O_MF32); bf16_t* HID = (bf16_t*)(p.ws + O_HID);
  const float* mod = (const float*)(p.ws + O_MOD);
  float* X = p.X;

  REP(0) {
#ifndef NO_MOD
  phase_mod(p, smem);
#endif
#ifndef NO_WCONV
  phase_wconv(p, 0, smem);
#endif
  }
  grid.sync();
  TICK(0)

  for (int l = 0; l < NL; ++l) {
    const float* modl = mod + (size_t)l * 4 * 6144;
    REP(1) {
#ifndef NO_WCONV
    if (l > 0) phase_wconv(p, l, smem);
#endif
#ifndef NO_NORM
    phase_norm(l == 0 ? p.in[0] : X, l == 0 ? X : nullptr, p.in[4] + l * DM, modl, 0, 1024, H);
#endif
    }
    gsync(bar, epoch); if ((DUP >> 20) & 1) gsync(bar, epoch); TICK(1)
    REP(2) {
#ifndef NO_GEMM1
      gemm_stream<true>(shm, DM, DM,
        [&](int i, GUnit& g) { const int u = blockIdx.x + i * (int)gridDim.x; if (u >= 64 * 49) return false; int pm, pn; tile_of(u, 64, 49, pm, pn);
          g.brow = pm * 256; g.bcol = pn * 256; g.nt = 16; g.aux = 0; g.keep = 0; g.cA = (const char*)(H + (size_t)g.brow * DM); g.cB = (const char*)(W + W_IN + (size_t)g.bcol * DM); return true; },
        [&](const GUnit& g, f32x4 (&acc)[2][2][4][2]) { const int brow = g.brow, bcol = g.bcol;
          EPI_PK( *(bf16x8*)(U + (size_t)row * LDU + col8) = pack8(v0, v1); ) });
#endif
    }
    gsync(bar, epoch); if ((DUP >> 20) & 1) gsync(bar, epoch); TICK(2)
    REP(11) {
#ifndef NO_HGPRE
    phase_hg_pre(p, l, smem);
#endif
    }
#if DIAG
    gsync(bar, epoch); if ((DUP >> 20) & 1) gsync(bar, epoch); TICK(11)
#endif
    REP(3) {
#ifndef NO_TOK64
    for (int it = blockIdx.x; it < 256; it += gridDim.x) pre_tok64(p, l, it, smem);
#endif
    }
    gsync(bar, epoch); if ((DUP >> 20) & 1) gsync(bar, epoch); TICK(3)
    { const int nb = gridDim.x;
#if DIAG
      for (int it = blockIdx.x; it < 128; it += nb) ssd_scan_item(p, l, it, smem);
      gsync(bar, epoch); if ((DUP >> 20) & 1) gsync(bar, epoch); TICK(14)
      for (int it = blockIdx.x + 128; it < 128 + 32 + 8; it += nb) {
#else
      for (int it = blockIdx.x; it < 128 + 32 + 8; it += nb) {
#endif
        if (it < 128) {
          REP(14) {
#ifndef NO_SSD
          ssd_scan_item(p, l, it, smem);
#endif
          }
        } else if (it < 160) {
          REP(12) {
#ifndef NO_HGSCAN
          hg_scan_item(p, it - 128, smem);
#endif
          }
        } else lru_carry_item(p, it - 160); }
#if DIAG
      gsync(bar, epoch); if ((DUP >> 20) & 1) gsync(bar, epoch); TICK(12)
#endif
      { float* rl = (float*)(smem + 16384); const float* rg = p.in[9] + (size_t)l * 8 * 465; __syncthreads();
        for (int i = threadIdx.x; i < 8 * 465; i += 512) rl[i] = rg[i]; __syncthreads(); }
      REP(4) { unsigned* q = bar + 16 + l + 8 * rep_;
      volatile int* slot = &s_item;
      __syncthreads(); if (threadIdx.x == 0) slot[0] = (int)atomicAdd(q, 1u); __syncthreads();
      int it = slot[0], par = 0;
      while (it < 512 + 1024) {
        if (threadIdx.x == 0) slot[par ^ 1] = (int)atomicAdd(q, 1u);
#ifndef NO_NA
        if (it < 512) ssd_diag_item(p, l, it, smem); else na_item(p, l, it - 512, smem);
#endif
        __syncthreads(); par ^= 1; it = slot[par];
      } } }
    gsync(bar, epoch); if ((DUP >> 20) & 1) gsync(bar, epoch); TICK(4)
    REP(5) {
#ifndef NO_FIN
    phase_finalize(p, l);
#endif
    }
    gsync(bar, epoch); if ((DUP >> 20) & 1) gsync(bar, epoch); TICK(5)
    REP(6) {
#ifndef NO_GEMM2
      gemm_stream<false>(shm, LDU, DM,
        [&](int i, GUnit& g) { const int u = blockIdx.x + (i >> 2) * (int)gridDim.x, seg = i & 3; if (u >= 64 * 4) return false; int pm, pn; tile_of(u, 64, 4, pm, pn);
          g.brow = pm * 256; g.bcol = pn * 256; g.nt = seg == 3 ? 16 : 8; g.aux = seg; g.keep = seg < 3;
          const int acol = seg == 0 ? C_YHG : (seg == 1 ? C_YNA : (seg == 2 ? C_YLR : C_YSS));
          g.cA = (const char*)(U + (size_t)g.brow * LDU + acol); g.cB = (const char*)(W + W_BRHG + (size_t)seg * 1024 * 1024 + (size_t)g.bcol * DM); return true; },
        [&](const GUnit& g, f32x4 (&acc)[2][2][4][2]) { const int brow = g.brow, bcol = g.bcol, seg = g.aux;
          if (seg < 3) {
#pragma unroll
            for (int ai = 0; ai < 2; ++ai)
#pragma unroll
              for (int m = 0; m < 4; ++m) { TIDL; const int wid = __builtin_amdgcn_readfirstlane(tid_ >> 6), lane = tid_ & 63, wr = wid >> 2, wc = wid & 3, fr = lane & 15, fq = lane >> 4;
                int row = brow + ai * 128 + wr * 64 + m * 16 + fr; asm volatile("" : "+v"(row));
                bf16x4 ga[4], gb[4];
#pragma unroll
                for (int bj = 0; bj < 2; ++bj)
#pragma unroll
                  for (int n = 0; n < 2; ++n) { const int col = bcol + bj * 128 + wc * 32 + n * 16 + fq * 4;
                    ga[bj * 2 + n] = ld4(U + (size_t)row * LDU + C_MRG + seg * 1024 + col); gb[bj * 2 + n] = ld4(U + (size_t)row * LDU + C_MRG + (seg + 1) * 1024 + col); }
#pragma unroll
                for (int bj = 0; bj < 2; ++bj)
#pragma unroll
                  for (int n = 0; n < 2; ++n)
#pragma unroll
                    for (int j = 0; j < 4; ++j) { const float za = bf2f((bf16_t)ga[bj * 2 + n][j]), zb = bf2f((bf16_t)gb[bj * 2 + n][j]);
                      acc[ai][bj][m][n][j] *= (1.f + __expf(fminf(-zb, 60.f))) * __builtin_amdgcn_rcpf(1.f + __expf(fminf(-za, 60.f))); }
                asm volatile("" ::: "memory"); }
          } else {
            EPI_LOOP( const bf16x4 gz = ld4(U + (size_t)row * LDU + C_MRG + 3 * 1024 + col); f32x4 r;
              for (int j = 0; j < 4; ++j) r[j] = v[j] * sigmoidf_(bf2f((bf16_t)gz[j]));
              *(bf16x4*)(H + (size_t)row * DM + col) = pack4(r); )
          } });
#endif
    }
    gsync(bar, epoch); if ((DUP >> 20) & 1) gsync(bar, epoch); TICK(6)
#ifndef NO_GEMM3
    gemm_stream<false>(shm, DM, DM,
      [&](int i, GUnit& g) { const int u = blockIdx.x + i * (int)gridDim.x; if (u >= 64 * 4) return false; int pm, pn; tile_of(u, 64, 4, pm, pn);
        g.brow = pm * 256; g.bcol = pn * 256; g.nt = 16; g.aux = 0; g.keep = 0; g.cA = (const char*)(H + (size_t)g.brow * DM); g.cB = (const char*)(W + W_OUT + (size_t)g.bcol * DM); return true; },
      [&](const GUnit& g, f32x4 (&acc)[2][2][4][2]) { const int brow = g.brow, bcol = g.bcol;
        epi_loop2<2>(acc, brow, bcol,
          [&](int row, int col) -> f32x4 { return *(const f32x4*)(X + (size_t)row * DM + col); },
          [&](int row, int col, f32x4 v, f32x4 L) { const f32x4 gt = *(const f32x4*)(modl + (row >> 12) * 6144 + 2048 + col); *(f32x4*)(X + (size_t)row * DM + col) = L + gt * v; }); });
#endif
    gsync(bar, epoch); if ((DUP >> 20) & 1) gsync(bar, epoch); TICK(7)
    REP(8) {
#ifndef NO_NORM
    phase_norm(X, nullptr, p.in[5] + l * DM, modl, 3072, 4096, H);
#endif
    }
    gsync(bar, epoch); if ((DUP >> 20) & 1) gsync(bar, epoch); TICK(8)
    REP(9) {
#ifndef NO_GEMM4
      gemm_stream<true>(shm, DM, DM,
        [&](int i, GUnit& g) { const int u = blockIdx.x + i * (int)gridDim.x; if (u >= 64 * 16) return false; int pm, pn; tile_of(u, 64, 16, pm, pn);
          g.brow = pm * 256; g.bcol = pn * 256; g.nt = 16; g.aux = 0; g.keep = 0; g.cA = (const char*)(H + (size_t)g.brow * DM); g.cB = (const char*)(W + W_FF1 + (size_t)g.bcol * DM); return true; },
        [&](const GUnit& g, f32x4 (&acc)[2][2][4][2]) { const int brow = g.brow, bcol = g.bcol;
          EPI_PK( f32x4 r0; f32x4 r1; for (int j = 0; j < 4; ++j) { const float t0 = fmaxf(v0[j], 0.f); const float t1 = fmaxf(v1[j], 0.f); r0[j] = t0 * t0; r1[j] = t1 * t1; }
            *(bf16x8*)(HID + (size_t)row * DFF + col8) = pack8(r0, r1); ) });
#endif
    }
    gsync(bar, epoch); if ((DUP >> 20) & 1) gsync(bar, epoch); TICK(9)
#ifndef NO_GEMM5
    gemm_stream<false>(shm, DFF, DFF,
      [&](int i, GUnit& g) { const int u = blockIdx.x + i * (int)gridDim.x; if (u >= 64 * 4) return false; int pm, pn; tile_of(u, 64, 4, pm, pn);
        g.brow = pm * 256; g.bcol = pn * 256; g.nt = 64; g.aux = 0; g.keep = 0; g.cA = (const char*)(HID + (size_t)g.brow * DFF); g.cB = (const char*)(W + W_FF2 + (size_t)g.bcol * DFF); return true; },
      [&](const GUnit& g, f32x4 (&acc)[2][2][4][2]) { const int brow = g.brow, bcol = g.bcol;
        epi_loop2<2>(acc, brow, bcol,
          [&](int row, int col) -> f32x4 { return *(const f32x4*)(X + (size_t)row * DM + col); },
          [&](int row, int col, f32x4 v, f32x4 L) { const f32x4 gt = *(const f32x4*)(modl + (row >> 12) * 6144 + 5120 + col); *(f32x4*)(X + (size_t)row * DM + col) = L + gt * v; }); });
#endif
    gsync(bar, epoch); if ((DUP >> 20) & 1) gsync(bar, epoch); TICK(10)
  }
#ifndef NO_NORM
  phase_final_norm(X, p.in[28]);
#endif
#if DIAG
  if (blockIdx.x == 0 && threadIdx.x == 0) { bar[32] = accx_; bar[33] = accy_; }
  gsync(bar, epoch);
  { const float vx = (float)bar[32] * 0.01f, vy = (float)bar[33] * 0.01f;
    for (size_t i = (size_t)blockIdx.x * 512 + threadIdx.x; i < (size_t)NT * DM; i += (size_t)gridDim.x * 512) X[i] = vy;
    gsync(bar, epoch);
    if (blockIdx.x == 0 && threadIdx.x == 0) X[0] = 10.f * vx; }
#endif
}

extern "C" void kernel_launch(void* const* d_in, const int* in_sizes, int n_in, void* d_out, int out_size,
                              void* d_ws, size_t ws_size, hipStream_t stream) {
  constexpr size_t kDynLds = 136 * 1024;
  static int grid_blocks = 0;
  if (!grid_blocks) {
    int dev = 0, cus = 0, per_cu = 0;
    (void)hipGetDevice(&dev);
    (void)hipDeviceGetAttribute(&cus, hipDeviceAttributeMultiprocessorCount, dev);
    (void)hipFuncSetAttribute((const void*)mk, hipFuncAttributeMaxDynamicSharedMemorySize, (int)kDynLds);
    (void)hipOccupancyMaxActiveBlocksPerMultiprocessor(&per_cu, mk, 512, kDynLds);
    if (per_cu < 1) per_cu = 1;
    grid_blocks = cus;
  }
  Params p{};
  for (int i = 0; i < 29; ++i) p.in[i] = (const float*)d_in[i];
  p.X = (float*)d_out; p.ws = (char*)d_ws;
  (void)hipMemsetAsync(d_ws, 0, 16384, stream);
  void* args[] = {&p};
  hipError_t e = hipLaunchCooperativeKernel((void*)mk, dim3(grid_blocks), dim3(512), args, kDynLds, stream);
  if (e != hipSuccess) fprintf(stderr, "cooperative launch failed: %s (grid %d)\n", hipGetErrorString(e), grid_blocks);
}
```

```cpp
#include <hip/hip_runtime.h>
#include <hip/hip_cooperative_groups.h>
#include <cstdio>
#include <cstdint>
namespace cg = cooperative_groups;
#ifndef DIAG
#define DIAG 0
#endif
#ifndef DUP
#define DUP 0
#endif
#define REP(id) _Pragma("nounroll") for (int rep_ = 0; rep_ < 1 + ((DUP >> (id)) & 1); ++rep_)
#ifndef TX
#define TX 4
#endif
#ifndef TY
#define TY 12
#endif

#define DEVI __device__ __forceinline__
#define LAS __attribute__((address_space(3)))
#define LAUNDER(x) asm volatile("" : "+s"(x))
#define WSP char* ws_ = p.ws; LAUNDER(ws_)
#define TIDL int tid_ = threadIdx.x; asm volatile("" : "+v"(tid_))
typedef unsigned short bf16_t;
typedef short bf16x8 __attribute__((ext_vector_type(8)));
typedef short bf16x4 __attribute__((ext_vector_type(4)));
typedef float f32x4 __attribute__((ext_vector_type(4)));
typedef unsigned u32x4 __attribute__((ext_vector_type(4)));
typedef unsigned u32x2 __attribute__((ext_vector_type(2)));

constexpr int DM = 1024, NB = 4, SEQ = 4096, NT = NB * SEQ, NL = 4, NIN = 12320, LDU = 12544, DFF = 4096;
constexpr float EPS = 1e-6f;
constexpr int C_HGQ = 0, C_HGZF = 512, C_HGZB = 1024, C_HGI = 1536, C_HGG = 2048, C_NAQ = 2560, C_NAK = 3072, C_NAV = 3584,
              C_LRX = 4096, C_LRG = 4608, C_SSZ = 5120, C_SSX = 6144, C_SSB = 7168, C_SSC = 7680, C_SSDT = 8192, C_MRG = 8224;
constexpr int C_YHG = 0, C_OF = 512, C_OB = 1024, C_YNA = 1536, C_YLR = 4096, C_YSF = 6144, C_YSB = 7168, C_YSS = 3072, C_YD0 = 0, C_YD1 = 4096;

constexpr size_t MiB = 1048576;
constexpr size_t O_BAR = 0;
constexpr size_t O_MOD = 16384;
constexpr size_t O_LBV = O_MOD + 4 * 4 * 6144 * 4;
constexpr size_t O_W = 1 * MiB;
constexpr size_t W_IN = 0, W_BRHG = W_IN + (size_t)LDU * 1024, W_BRNA = W_BRHG + 1024 * 1024, W_BRLR = W_BRNA + 1024 * 1024,
                 W_BRSS = W_BRLR + 1024 * 1024, W_OUT = W_BRSS + 1024 * 1024, W_FF1 = W_OUT + 1024 * 1024, W_FF2 = W_FF1 + 4096 * 1024,
                 W_LRG = W_FF2 + 4096 * 1024, W_END = W_LRG + 32 * 4096;
constexpr size_t O_U = O_W + 51 * MiB;
constexpr size_t O_H = O_U + (size_t)NT * LDU * 2;
constexpr size_t O_QT = O_H + 32 * MiB;
constexpr size_t O_KC = O_QT + 32 * MiB;
constexpr size_t O_KT = O_KC + 32 * MiB;
constexpr size_t O_VT = O_KT + 32 * MiB;
constexpr size_t O_DEC = O_VT + 16 * MiB;
constexpr size_t O_VTN = O_DEC + 4 * MiB;
constexpr size_t O_HL = O_VTN + 16 * MiB;
constexpr size_t O_PP = O_HL + 32 * MiB;
constexpr size_t O_CP = O_PP + 32 * MiB;
constexpr size_t O_CH = O_CP + 1 * MiB;
constexpr size_t O_CIN = O_CH + 1 * MiB;
constexpr size_t O_XST = O_CIN + 1 * MiB;
constexpr size_t O_BM = O_XST + 32 * MiB;
constexpr size_t O_CM = O_BM + 16 * MiB;
constexpr size_t O_BT = O_CM + 16 * MiB;
constexpr size_t O_DT = O_BT + 16 * MiB;
constexpr size_t O_AA = O_DT + 2 * MiB;
constexpr size_t O_END = O_AA + 2 * MiB;
constexpr size_t O_MF32 = O_QT;
constexpr size_t O_HID = O_U;
static_assert(W_END * 2 <= 51 * MiB, "weights region");
static_assert(O_END <= 770 * MiB, "workspace");

struct Params {
  const float* in[29];
  float* X;
  char* ws;
};

DEVI float bf2f(bf16_t h) { return __uint_as_float((unsigned)h << 16); }
typedef float f32x2_ __attribute__((ext_vector_type(2)));
typedef __bf16 bf16v2_ __attribute__((ext_vector_type(2)));
DEVI unsigned cvt_pk_bf16(float lo, float hi) { const f32x2_ v = {lo, hi}; const bf16v2_ r = __builtin_convertvector(v, bf16v2_); return __builtin_bit_cast(unsigned, r); }
DEVI bf16_t f2bf(float f) { return (bf16_t)(cvt_pk_bf16(f, 0.f) & 0xffffu); }
DEVI float sigmoidf_(float x) { return __builtin_amdgcn_rcpf(1.f + __expf(-x)); }
DEVI float siluf_(float x) { return x * __builtin_amdgcn_rcpf(1.f + __expf(-x)); }
DEVI float softplusf_(float x) { return x > 20.f ? x : log1pf(__expf(x)); }
DEVI float gelu_tanh(float x) { float u = 0.7978845608028654f * (x + 0.044715f * x * x * x); float e = __expf(2.f * u); float th = 1.f - 2.f * __builtin_amdgcn_rcpf(e + 1.f); return 0.5f * x * (1.f + th); }
DEVI float wave_sum(float v) { for (int o = 32; o > 0; o >>= 1) v += __shfl_xor(v, o); return v; }
DEVI bf16x8 cat4(bf16x4 a, bf16x4 b) { return __builtin_shufflevector(a, b, 0, 1, 2, 3, 4, 5, 6, 7); }
DEVI bf16x4 pack4(f32x4 v) { u32x2 r; r.x = cvt_pk_bf16(v[0], v[1]); r.y = cvt_pk_bf16(v[2], v[3]); return __builtin_bit_cast(bf16x4, r); }
DEVI bf16x8 pack8(f32x4 a, f32x4 b) { u32x4 r; r.x = cvt_pk_bf16(a[0], a[1]); r.y = cvt_pk_bf16(a[2], a[3]); r.z = cvt_pk_bf16(b[0], b[1]); r.w = cvt_pk_bf16(b[2], b[3]); return __builtin_bit_cast(bf16x8, r); }
DEVI f32x4 mfma32(bf16x8 a, bf16x8 b, f32x4 c) { return __builtin_amdgcn_mfma_f32_16x16x32_bf16(a, b, c, 0, 0, 0); }
DEVI f32x4 mfma16(bf16x4 a, bf16x4 b, f32x4 c) { return __builtin_amdgcn_mfma_f32_16x16x16bf16_1k(a, b, c, 0, 0, 0); }
DEVI bf16x8 ld8(const bf16_t* p) { return *(const bf16x8*)p; }
DEVI bf16x4 ld4(const bf16_t* p) { return *(const bf16x4*)p; }

#define XB_TMO      128
#define XB_XCNT(j)  (256  + 64 * (j))
#define XB_XSUB(j)  (1280 + 64 * (j))
#define XB_XGEN(j)  (2304 + 64 * (j))
#define XB_TOP      3328
#define XB_TOPGEN   3392
#define XB_SPIN_CAP (1u << 22)
DEVI unsigned xb_ld(unsigned* p) { return __hip_atomic_load(p, __ATOMIC_RELAXED, __HIP_MEMORY_SCOPE_AGENT); }
DEVI unsigned xb_add(unsigned* p, unsigned v) { return __hip_atomic_fetch_add(p, v, __ATOMIC_RELAXED, __HIP_MEMORY_SCOPE_AGENT); }
DEVI unsigned xb_xcc_id() { return (unsigned)__builtin_amdgcn_s_getreg((3 << 11) | 20) & 0xFu; }
#define XB_SPIN(cond, bar) do { unsigned _sp = 0; while (cond) { __builtin_amdgcn_s_sleep(1); \
    if ((++_sp & 255u) == 0u) { if (xb_ld(&(bar)[XB_TMO])) break; if (_sp > XB_SPIN_CAP) { atomicAdd(&(bar)[XB_TMO], 1u); break; } } } } while (0)
struct XcdBarrier { unsigned* bar; unsigned x; volatile LAS unsigned* st; };
DEVI XcdBarrier xcd_barrier_post(unsigned* bar, volatile LAS unsigned* st) {
  XcdBarrier b; b.bar = bar; b.x = xb_xcc_id(); b.st = st;
  if (threadIdx.x == 0) (void)xb_add(&bar[XB_XCNT(b.x)], 1u);
  return b;
}
DEVI void xcd_barrier_complete(unsigned* bar, unsigned x, unsigned& nloc, unsigned& nx) {
  const unsigned G = gridDim.x; unsigned sum, cnt, mine, sp = 0u;
  for (;;) { sum = 0u; cnt = 0u; mine = 0u;
#pragma unroll
    for (unsigned j = 0; j < 16; ++j) { const unsigned c = xb_ld(&bar[XB_XCNT(j)]); sum += c; cnt += (c > 0u) ? 1u : 0u; mine = (j == x) ? c : mine; }
    if (sum == G) break;
    __builtin_amdgcn_s_sleep(1);
    if ((++sp & 255u) == 0u) { if (xb_ld(&bar[XB_TMO])) break; if (sp > XB_SPIN_CAP) { atomicAdd(&bar[XB_TMO], 1u); break; } } }
  nloc = mine > 0u ? mine : 1u; nx = cnt > 0u ? cnt : 1u;
}
DEVI void xcd_barrier(const XcdBarrier& b) {
  asm volatile("s_waitcnt vmcnt(0)" ::: "memory");
  __syncthreads();
  if (threadIdx.x == 0) {
    unsigned* bar = b.bar;
    __builtin_amdgcn_s_waitcnt(0);
    unsigned nloc = b.st[0], nx = b.st[1];
    if (nloc == 0u) { xcd_barrier_complete(bar, b.x, nloc, nx); b.st[0] = nloc; b.st[1] = nx; }
    const unsigned old = xb_add(&bar[XB_XSUB(b.x)], 1u);
    const unsigned gen = old / nloc;
    if (old + 1u == (gen + 1u) * nloc) {
      __builtin_amdgcn_fence(__ATOMIC_RELEASE, "agent");
      asm volatile("s_waitcnt vmcnt(0)" ::: "memory");
      const unsigned og = xb_add(&bar[XB_TOP], 1u);
      const unsigned tg = og / nx;
      if (og + 1u == (tg + 1u) * nx) xb_add(&bar[XB_TOPGEN], 1u);
      else XB_SPIN(xb_ld(&bar[XB_TOPGEN]) == tg, bar);
      __builtin_amdgcn_fence(__ATOMIC_ACQUIRE, "agent");
      xb_add(&bar[XB_XGEN(b.x)], 1u);
      asm volatile("s_waitcnt vmcnt(0)" ::: "memory");
    } else {
      XB_SPIN(xb_ld(&bar[XB_XGEN(b.x)]) == gen, bar);
      __builtin_amdgcn_fence(__ATOMIC_ACQUIRE, "agent");
      asm volatile("s_waitcnt vmcnt(0)" ::: "memory");
    }
  }
  __syncthreads();
}
#define gsync(bar_, epoch_) xcd_barrier(xb)

constexpr int HTB = 128 * 64 * 2;
DEVI int lds_byte(int r, int c) { int st = (r >> 4) * 2 + (c >> 5), rr = r & 15, cc = c & 31, ob = rr * 64 + cc * 2; return st * 1024 + (ob ^ (((ob >> 9) & 1) << 5)); }
DEVI void stage_rc(int b, int& R, int& C) { int st = b / 1024, sb = b % 1024, swz = sb ^ (((sb >> 9) & 1) << 5); R = (st >> 1) * 16 + swz / 64; C = (st & 1) * 32 + (swz % 64) / 2; }

#define SA(b, h) (((b) * 2 + (h)) * HTB)
#define SB(b, h) ((4 + (b) * 2 + (h)) * HTB)
#define STAGE(bufoff, gbase, voff) do { _Pragma("unroll") for (int _i = 0; _i < 2; ++_i) \
    __builtin_amdgcn_global_load_lds((const unsigned*)((const char*)(gbase) + (voff)[_i]), (LAS unsigned*)(shm + (bufoff) + ldsw + _i * 8192), 16, 0, 0); } while (0)
#define LDA(dst, b, h) do { _Pragma("unroll") for (int m = 0; m < 4; ++m) _Pragma("unroll") for (int k = 0; k < 2; ++k) dst[m][k] = *(const LAS bf16x8*)(shm + SA(b, h) + aoff + m * 2048 + k * 1024); } while (0)
#define LDB(dst, b, h) do { _Pragma("unroll") for (int n = 0; n < 2; ++n) _Pragma("unroll") for (int k = 0; k < 2; ++k) dst[n][k] = *(const LAS bf16x8*)(shm + SB(b, h) + boff + n * 2048 + k * 1024); } while (0)
#define MMA(ai, bj, At_, Bt_) do { __builtin_amdgcn_s_setprio(1); \
    _Pragma("unroll") for (int m = 0; m < 4; ++m) _Pragma("unroll") for (int n = 0; n < 2; ++n) _Pragma("unroll") for (int k = 0; k < 2; ++k) \
      acc[ai][bj][m][n] = __builtin_amdgcn_mfma_f32_16x16x32_bf16(Bt_[n][k], At_[m][k], acc[ai][bj][m][n], 0, 0, 0); \
    __builtin_amdgcn_s_setprio(0); } while (0)
#define WAIT_V(n) asm volatile("s_waitcnt vmcnt(" #n ")" ::: "memory")
#define WAIT_L(n) asm volatile("s_waitcnt lgkmcnt(" #n ")" ::: "memory")
#define BAR __builtin_amdgcn_s_barrier()
#define SCHED __builtin_amdgcn_sched_barrier(0)

DEVI void gemm_tile(const bf16_t* A, int lda, const bf16_t* Bt, int ldb, int K, int brow, int bcol, f32x4 (&acc)[2][2][4][2], LAS char* shm) {
  TIDL; const int tid = tid_, wid = __builtin_amdgcn_readfirstlane(tid >> 6), lane = tid & 63, wr = wid >> 2, wc = wid & 3, fr = lane & 15, fq = lane >> 4;
#pragma unroll
  for (int a = 0; a < 2; ++a)
#pragma unroll
    for (int b = 0; b < 2; ++b)
#pragma unroll
      for (int m = 0; m < 4; ++m)
#pragma unroll
        for (int n = 0; n < 2; ++n) acc[a][b][m][n] = (f32x4){0.f, 0.f, 0.f, 0.f};
  unsigned voffA[2], voffB[2];
#pragma unroll
  for (int i = 0; i < 2; ++i) { int R, C; stage_rc(tid * 16 + i * 8192, R, C); voffA[i] = (unsigned)(R * lda + C) * 2u; voffB[i] = (unsigned)(R * ldb + C) * 2u; }
  const size_t kstep = 128, hstepA = (size_t)128 * lda * 2, hstepB = (size_t)128 * ldb * 2;
  const unsigned ldsw = (unsigned)wid * 1024u;
  const int aoff = lds_byte(wr * 64 + fr, fq * 8), boff = lds_byte(wc * 32 + fr, fq * 8);
  const char* cA = (const char*)A + (size_t)brow * lda * 2; const char* cB = (const char*)Bt + (size_t)bcol * ldb * 2;
  bf16x8 At[4][2], B0[2][2], B1[2][2];
  const int nt = K / 64;
  STAGE(SB(0, 0), cB, voffB); STAGE(SA(0, 0), cA, voffA); STAGE(SB(0, 1), cB + hstepB, voffB); STAGE(SA(0, 1), cA + hstepA, voffA);
  if (wr == 1) BAR;
  WAIT_V(4); BAR;
  STAGE(SB(1, 0), cB + kstep, voffB); STAGE(SA(1, 0), cA + kstep, voffA); STAGE(SB(1, 1), cB + hstepB + kstep, voffB);
  WAIT_V(6); BAR;
  for (int t = 0; t < nt - 2; t += 2) {
    const char* a1 = cA + (size_t)(t + 1) * kstep; const char* a2 = cA + (size_t)(t + 2) * kstep; const char* b2 = cB + (size_t)(t + 2) * kstep;
    const char* a3 = a2 + kstep; const char* b3 = b2 + kstep;
    LDB(B0, 0, 0); SCHED; LDA(At, 0, 0); STAGE(SA(1, 1), a1 + hstepA, voffA);
    WAIT_L(8); BAR; WAIT_L(0); MMA(0, 0, At, B0); BAR; SCHED;
    LDB(B1, 0, 1); STAGE(SB(0, 0), b2, voffB);
    BAR; WAIT_L(0); MMA(0, 1, At, B1); BAR;
    LDA(At, 0, 1); STAGE(SA(0, 0), a2, voffA);
    BAR; WAIT_L(0); MMA(1, 0, At, B0); BAR; SCHED;
    STAGE(SB(0, 1), b2 + hstepB, voffB);
    WAIT_V(6); BAR; MMA(1, 1, At, B1); BAR;
    LDB(B0, 1, 0); SCHED; LDA(At, 1, 0); STAGE(SA(0, 1), a2 + hstepA, voffA);
    WAIT_L(8); BAR; WAIT_L(0); MMA(0, 0, At, B0); BAR; SCHED;
    LDB(B1, 1, 1); STAGE(SB(1, 0), b3, voffB);
    BAR; WAIT_L(0); MMA(0, 1, At, B1); BAR;
    LDA(At, 1, 1); STAGE(SA(1, 0), a3, voffA);
    BAR; WAIT_L(0); MMA(1, 0, At, B0); BAR; SCHED;
    STAGE(SB(1, 1), b3 + hstepB, voffB);
    WAIT_V(6); BAR; MMA(1, 1, At, B1); BAR;
  }
  { const char* a1 = cA + (size_t)(nt - 1) * kstep;
    LDB(B0, 0, 0); LDA(At, 0, 0); STAGE(SA(1, 1), a1 + hstepA, voffA);
    BAR; WAIT_L(0); MMA(0, 0, At, B0); BAR;
    LDB(B1, 0, 1); BAR; WAIT_L(0); MMA(0, 1, At, B1); BAR;
    LDA(At, 0, 1); WAIT_V(4); BAR; WAIT_L(0); MMA(1, 0, At, B0); MMA(1, 1, At, B1); BAR; }
  { LDB(B0, 1, 0); LDA(At, 1, 0); WAIT_V(2); BAR; WAIT_L(0); MMA(0, 0, At, B0); BAR;
    LDB(B1, 1, 1); WAIT_V(0); BAR; WAIT_L(0); MMA(0, 1, At, B1); BAR;
    LDA(At, 1, 1); BAR; WAIT_L(0); MMA(1, 0, At, B0); MMA(1, 1, At, B1); BAR; }
  if (wr == 0) BAR;
}

struct GUnit { const char* cA; const char* cB; int nt, brow, bcol, aux, keep; };
DEVI int perm32(int rho) { const int n = rho >> 4, i = rho & 15; return 8 * (i >> 2) + 4 * n + (i & 3); }
template <bool PERM, class UF, class EF>
DEVI void gemm_stream(LAS char* shm, int lda, int ldb, UF unit, EF epi) {
  TIDL; const int tid = tid_, wid = __builtin_amdgcn_readfirstlane(tid >> 6), lane = tid & 63, wr = wid >> 2, wc = wid & 3, fr = lane & 15, fq = lane >> 4;
  GUnit cur, nxt; int ui = 0;
  if (!unit(0, cur)) return;
  f32x4 acc[2][2][4][2];
#pragma unroll
  for (int a = 0; a < 2; ++a)
#pragma unroll
    for (int b = 0; b < 2; ++b)
#pragma unroll
      for (int m = 0; m < 4; ++m)
#pragma unroll
        for (int n = 0; n < 2; ++n) acc[a][b][m][n] = (f32x4){0.f, 0.f, 0.f, 0.f};
  unsigned voffA[2], voffB[2];
#pragma unroll
  for (int i = 0; i < 2; ++i) { int R, C; stage_rc(tid * 16 + i * 8192, R, C); const int Rb = PERM ? ((R & ~31) + perm32(R & 31)) : R; voffA[i] = (unsigned)(R * lda + C) * 2u; voffB[i] = (unsigned)(Rb * ldb + C) * 2u; }
  const size_t kstep = 128, hstepA = (size_t)128 * lda * 2, hstepB = (size_t)128 * ldb * 2;
  const unsigned ldsw = (unsigned)wid * 1024u;
  const int aoff = lds_byte(wr * 64 + fr, fq * 8), boff = lds_byte(wc * 32 + fr, fq * 8);
  bf16x8 At[4][2], B0[2][2], B1[2][2];
  { const char* cA = cur.cA; const char* cB = cur.cB;
    STAGE(SB(0, 0), cB, voffB); STAGE(SA(0, 0), cA, voffA); STAGE(SB(0, 1), cB + hstepB, voffB); STAGE(SA(0, 1), cA + hstepA, voffA);
    if (wr == 1) BAR;
    WAIT_V(4); BAR;
    STAGE(SB(1, 0), cB + kstep, voffB); STAGE(SA(1, 0), cA + kstep, voffA); STAGE(SB(1, 1), cB + hstepB + kstep, voffB);
    WAIT_V(6); BAR; }
  for (;;) {
    const bool has_next = unit(ui + 1, nxt);
    const char* cA = cur.cA; const char* cB = cur.cB;
    const char* nA = has_next ? nxt.cA : cA; const char* nB = has_next ? nxt.cB : cB;
    const int nt = cur.nt;
#pragma nounroll
    for (int t = 0; t < nt; t += 2) {
      const bool last = (t == nt - 2);
      const char* a1 = cA + (size_t)(t + 1) * kstep;
      const char* a2 = last ? nA : cA + (size_t)(t + 2) * kstep; const char* b2 = last ? nB : cB + (size_t)(t + 2) * kstep;
      const char* a3 = a2 + kstep; const char* b3 = b2 + kstep;
      LDB(B0, 0, 0); SCHED; LDA(At, 0, 0); STAGE(SA(1, 1), a1 + hstepA, voffA);
      WAIT_L(8); BAR; WAIT_L(0); MMA(0, 0, At, B0); BAR; SCHED;
      LDB(B1, 0, 1); STAGE(SB(0, 0), b2, voffB);
      BAR; WAIT_L(0); MMA(0, 1, At, B1); BAR;
      LDA(At, 0, 1); STAGE(SA(0, 0), a2, voffA);
      BAR; WAIT_L(0); MMA(1, 0, At, B0); BAR; SCHED;
      STAGE(SB(0, 1), b2 + hstepB, voffB);
      WAIT_V(6); BAR; MMA(1, 1, At, B1); BAR;
      LDB(B0, 1, 0); SCHED; LDA(At, 1, 0); STAGE(SA(0, 1), a2 + hstepA, voffA);
      WAIT_L(8); BAR; WAIT_L(0); MMA(0, 0, At, B0); BAR; SCHED;
      LDB(B1, 1, 1); STAGE(SB(1, 0), b3, voffB);
      BAR; WAIT_L(0); MMA(0, 1, At, B1); BAR;
      LDA(At, 1, 1); STAGE(SA(1, 0), a3, voffA);
      BAR; WAIT_L(0); MMA(1, 0, At, B0); BAR; SCHED;
      STAGE(SB(1, 1), b3 + hstepB, voffB);
      WAIT_V(6); BAR; MMA(1, 1, At, B1); BAR;
    }
    epi(cur, acc);
    if (!has_next) break;
    if (!cur.keep)
#pragma unroll
    for (int a = 0; a < 2; ++a)
#pragma unroll
      for (int b = 0; b < 2; ++b)
#pragma unroll
        for (int m = 0; m < 4; ++m)
#pragma unroll
          for (int n = 0; n < 2; ++n) acc[a][b][m][n] = (f32x4){0.f, 0.f, 0.f, 0.f};
    cur = nxt; ++ui;
  }
  WAIT_V(0);
  if (wr == 0) BAR;
  BAR;
}

DEVI void tile_of(int u, int nM, int nN, int& pm, int& pn) {
  const int nwg = nM * nN; int wgid = u;
  { const int q = nwg / 8, r = nwg % 8, xcd = wgid % 8, off = wgid / 8; wgid = (xcd < r ? xcd * (q + 1) : r * (q + 1) + (xcd - r) * q) + off; }
  const int nig = 8 * nN, gid = wgid / nig, fm = gid * 8, gsz = (nM - fm) < 8 ? (nM - fm) : 8;
  pm = fm + ((wgid % nig) % gsz); pn = (wgid % nig) / gsz;
}

template <int GM, bool PERM, class LF, class BF>
DEVI void epi_loop2(f32x4 (&acc)[2][2][4][2], int brow, int bcol, LF loadf, BF bodyf) {
  TIDL; const int wid = __builtin_amdgcn_readfirstlane(tid_ >> 6), lane = tid_ & 63, wr = wid >> 2, wc = wid & 3, fr = lane & 15, fq = lane >> 4;
#pragma unroll
  for (int ai = 0; ai < 2; ++ai)
#pragma unroll
    for (int mg = 0; mg < 4; mg += GM) {
      int rowb = brow + ai * 128 + wr * 64 + mg * 16 + fr; asm volatile("" : "+v"(rowb));
      f32x4 ld_[GM][4];
#pragma unroll
      for (int mm = 0; mm < GM; ++mm)
#pragma unroll
        for (int bj = 0; bj < 2; ++bj)
#pragma unroll
          for (int n = 0; n < 2; ++n) ld_[mm][bj * 2 + n] = loadf(rowb + mm * 16, bcol + bj * 128 + wc * 32 + (PERM ? fq * 8 + n * 4 : n * 16 + fq * 4));
#pragma unroll
      for (int mm = 0; mm < GM; ++mm)
#pragma unroll
        for (int bj = 0; bj < 2; ++bj)
#pragma unroll
          for (int n = 0; n < 2; ++n) bodyf(rowb + mm * 16, bcol + bj * 128 + wc * 32 + (PERM ? fq * 8 + n * 4 : n * 16 + fq * 4), acc[ai][bj][mg + mm][n], ld_[mm][bj * 2 + n]);
      asm volatile("" ::: "memory");
    }
}
#define EPI_PK(BODY) { TIDL; const int wid = __builtin_amdgcn_readfirstlane(tid_ >> 6), lane = tid_ & 63, wr = wid >> 2, wc = wid & 3, fr = lane & 15, fq = lane >> 4; \
  _Pragma("unroll") for (int ai = 0; ai < 2; ++ai) _Pragma("unroll") for (int m = 0; m < 4; ++m) { \
    int row = brow + ai * 128 + wr * 64 + m * 16 + fr; asm volatile("" : "+v"(row)); \
    _Pragma("unroll") for (int bj = 0; bj < 2; ++bj) { \
      const int col8 = bcol + bj * 128 + wc * 32 + fq * 8; const f32x4 v0 = acc[ai][bj][m][0], v1 = acc[ai][bj][m][1]; BODY } asm volatile("" ::: "memory"); } }
#define EPI_LOOP(BODY) { TIDL; const int wid = __builtin_amdgcn_readfirstlane(tid_ >> 6), lane = tid_ & 63, wr = wid >> 2, wc = wid & 3, fr = lane & 15, fq = lane >> 4; \
  _Pragma("unroll") for (int ai = 0; ai < 2; ++ai) _Pragma("unroll") for (int m = 0; m < 4; ++m) { \
    int row = brow + ai * 128 + wr * 64 + m * 16 + fr; asm volatile("" : "+v"(row)); \
    _Pragma("unroll") for (int bj = 0; bj < 2; ++bj) _Pragma("unroll") for (int n = 0; n < 2; ++n) { \
      const int col = bcol + bj * 128 + wc * 32 + n * 16 + fq * 4; f32x4 v = acc[ai][bj][m][n]; BODY } asm volatile("" ::: "memory"); } }

DEVI void phase_mod(const Params& p, char* smem) {
  TIDL;
  WSP;
  float* cs = (float*)smem; float* red = cs + 4096;
  const float* c = p.in[1]; const float* w_ada = p.in[2]; const float* b_ada = p.in[3];
  float* mod = (float*)(ws_ + O_MOD);
  for (int i = tid_; i < 4096; i += 512) cs[i] = siluf_(c[i]);
  __syncthreads();
  const int col = tid_ & 63, kg = tid_ >> 6;
  for (int it = blockIdx.x; it < 4 * 96; it += gridDim.x) {
    const int l = it / 96, cb = it % 96, j = cb * 64 + col;
    const float* w = w_ada + (size_t)l * 1024 * 6144 + j;
    float a0 = 0, a1 = 0, a2 = 0, a3 = 0;
#pragma unroll 8
    for (int k = kg * 128; k < kg * 128 + 128; ++k) { const float wv = w[(size_t)k * 6144]; a0 += cs[k] * wv; a1 += cs[1024 + k] * wv; a2 += cs[2048 + k] * wv; a3 += cs[3072 + k] * wv; }
    red[(kg * 64 + col) * 4 + 0] = a0; red[(kg * 64 + col) * 4 + 1] = a1; red[(kg * 64 + col) * 4 + 2] = a2; red[(kg * 64 + col) * 4 + 3] = a3;
    __syncthreads();
    if (tid_ < 256) { const int c2 = tid_ & 63, b = tid_ >> 6; float s = 0;
      for (int g = 0; g < 8; ++g) s += red[(g * 64 + c2) * 4 + b];
      mod[(l * 4 + b) * 6144 + cb * 64 + c2] = s + b_ada[l * 6144 + cb * 64 + c2]; }
    __syncthreads();
  }
  if (blockIdx.x == gridDim.x - 1) {
    const float* hg_lb = p.in[7]; float* lbv = (float*)(ws_ + O_LBV);
    for (int i = tid_; i < 1024; i += 512) { const int dir = i >> 9, k = i & 511;
      float v[4], mx = -1e30f; for (int l = 0; l < 4; ++l) { v[l] = hg_lb[(dir * 4 + l) * 512 + k]; mx = fmaxf(mx, v[l]); }
      float s = 0; for (int l = 0; l < 4; ++l) { v[l] = __expf(v[l] - mx); s += v[l]; }
      float cum = 0; lbv[(dir * 4 + 0) * 512 + k] = 0.f;
      for (int l = 1; l < 4; ++l) { cum += v[l]; lbv[(dir * 4 + l) * 512 + k] = cum / s; } }
  }
}

DEVI void tconv_batch4(const float* src, int K, int N, bf16_t* dst, int ldd, int ntn, int i0, float* tiles) {
  TIDL; const int tid = tid_;
  f32x4 v[4][2];
  const int kr = tid >> 4, nc = (tid & 15) * 4;
#pragma unroll
  for (int q = 0; q < 4; ++q) { const int k0 = ((i0 + q) / ntn) * 64, n0 = ((i0 + q) % ntn) * 64;
#pragma unroll
    for (int i = 0; i < 2; ++i) { const int k = kr + i * 32; v[q][i] = (f32x4){0.f, 0.f, 0.f, 0.f};
      if (n0 + nc < N) v[q][i] = *(const f32x4*)(src + (size_t)(k0 + k) * N + n0 + nc); } }
#pragma unroll
  for (int q = 0; q < 4; ++q) { float* tile = tiles + q * 4160;
#pragma unroll
    for (int i = 0; i < 2; ++i) { const int k = kr + i * 32;
      tile[k * 65 + nc + 0] = v[q][i][0]; tile[k * 65 + nc + 1] = v[q][i][1]; tile[k * 65 + nc + 2] = v[q][i][2]; tile[k * 65 + nc + 3] = v[q][i][3]; } }
  __syncthreads();
#pragma unroll
  for (int q = 0; q < 4; ++q) { const int k0 = ((i0 + q) / ntn) * 64, n0 = ((i0 + q) % ntn) * 64; const float* tile = tiles + q * 4160;
    const int n = tid >> 3, k8 = (tid & 7) * 8; u32x4 w;
    w.x = cvt_pk_bf16(tile[(k8 + 0) * 65 + n], tile[(k8 + 1) * 65 + n]); w.y = cvt_pk_bf16(tile[(k8 + 2) * 65 + n], tile[(k8 + 3) * 65 + n]);
    w.z = cvt_pk_bf16(tile[(k8 + 4) * 65 + n], tile[(k8 + 5) * 65 + n]); w.w = cvt_pk_bf16(tile[(k8 + 6) * 65 + n], tile[(k8 + 7) * 65 + n]);
    *(u32x4*)(dst + (size_t)(n0 + n) * ldd + k0 + k8) = w; }
  __syncthreads();
}
DEVI void phase_wconv(const Params& p, int l, char* smem) {
  WSP;
  float* tile = (float*)smem; bf16_t* W = (bf16_t*)(ws_ + O_W);
  for (int g = blockIdx.x; g < 6112 / 4; g += gridDim.x) {
    int i = g * 4;
    if (i < 3136) { tconv_batch4(p.in[6] + (size_t)l * 1024 * NIN, 1024, NIN, W + W_IN, 1024, 196, i, tile); continue; } i -= 3136;
    if (i < 128) { tconv_batch4(p.in[21] + (size_t)l * 512 * 1024, 512, 1024, W + W_BRHG, 1024, 16, i, tile); continue; } i -= 128;
    if (i < 128) { tconv_batch4(p.in[22] + (size_t)l * 512 * 1024, 512, 1024, W + W_BRNA, 1024, 16, i, tile); continue; } i -= 128;
    if (i < 128) { tconv_batch4(p.in[23] + (size_t)l * 512 * 1024, 512, 1024, W + W_BRLR, 1024, 16, i, tile); continue; } i -= 128;
    if (i < 256) { tconv_batch4(p.in[24] + (size_t)l * 1024 * 1024, 1024, 1024, W + W_BRSS, 1024, 16, i, tile); continue; } i -= 256;
    if (i < 256) { tconv_batch4(p.in[25] + (size_t)l * 1024 * 1024, 1024, 1024, W + W_OUT, 1024, 16, i, tile); continue; } i -= 256;
    if (i < 1024) { tconv_batch4(p.in[26] + (size_t)l * 1024 * 4096, 1024, 4096, W + W_FF1, 1024, 64, i, tile); continue; } i -= 1024;
    if (i < 1024) { tconv_batch4(p.in[27] + (size_t)l * 4096 * 1024, 4096, 1024, W + W_FF2, 4096, 16, i, tile); continue; } i -= 1024;
    tconv_batch4(p.in[12] + (size_t)l * 32 * 4096, 64 * 32, 64, W + W_LRG, 2048, 1, i, tile);
  }
}

DEVI void phase_norm(const float* src, float* xcopy, const float* g, const float* mod, int shift_off, int scale_off, bf16_t* H) {
  TIDL;
  const int wid = tid_ >> 6, lane = tid_ & 63;
  const int stride = gridDim.x * 8;
  for (int row = blockIdx.x * 8 + wid; row < NT; row += 2 * stride) {
    const int row2 = row + stride;
    const bool has2 = row2 < NT;
    f32x4 v[2][4]; float ss[2] = {0.f, 0.f};
#pragma unroll
    for (int rr = 0; rr < 2; ++rr)
#pragma unroll
      for (int i = 0; i < 4; ++i) { v[rr][i] = (rr == 0 || has2) ? *(const f32x4*)(src + (size_t)(rr ? row2 : row) * DM + i * 256 + lane * 4) : (f32x4){0.f, 0.f, 0.f, 0.f}; }
#pragma unroll
    for (int rr = 0; rr < 2; ++rr)
#pragma unroll
      for (int i = 0; i < 4; ++i) ss[rr] += v[rr][i][0] * v[rr][i][0] + v[rr][i][1] * v[rr][i][1] + v[rr][i][2] * v[rr][i][2] + v[rr][i][3] * v[rr][i][3];
    ss[0] = wave_sum(ss[0]); ss[1] = wave_sum(ss[1]);
#pragma unroll
    for (int rr = 0; rr < 2; ++rr) { if (rr == 1 && !has2) break;
      const int rw = rr ? row2 : row; const float r = rsqrtf(ss[rr] * (1.f / DM) + EPS);
      const float* mb = mod + (rw >> 12) * 6144;
#pragma unroll
      for (int i = 0; i < 4; ++i) { const int c = i * 256 + lane * 4;
        if (xcopy) *(f32x4*)(xcopy + (size_t)rw * DM + c) = v[rr][i];
        const f32x4 gg = *(const f32x4*)(g + c), sc = *(const f32x4*)(mb + scale_off + c), sh = *(const f32x4*)(mb + shift_off + c);
        f32x4 y; for (int j = 0; j < 4; ++j) y[j] = v[rr][i][j] * r * gg[j] * (1.f + sc[j]) + sh[j];
        *(bf16x4*)(H + (size_t)rw * DM + c) = pack4(y); } }
  }
}

DEVI void phase_final_norm(float* X, const float* g) {
  TIDL;
  const int wid = tid_ >> 6, lane = tid_ & 63;
  for (int row = blockIdx.x * 8 + wid; row < NT; row += gridDim.x * 8) {
    f32x4 v[4]; float ss = 0.f;
#pragma unroll
    for (int i = 0; i < 4; ++i) { v[i] = *(const f32x4*)(X + (size_t)row * DM + i * 256 + lane * 4); ss += v[i][0] * v[i][0] + v[i][1] * v[i][1] + v[i][2] * v[i][2] + v[i][3] * v[i][3]; }
    ss = wave_sum(ss); const float r = rsqrtf(ss * (1.f / DM) + EPS);
#pragma unroll
    for (int i = 0; i < 4; ++i) { const int c = i * 256 + lane * 4; const f32x4 gg = *(const f32x4*)(g + c);
      f32x4 y; for (int j = 0; j < 4; ++j) y[j] = v[i][j] * r * gg[j];
      *(f32x4*)(X + (size_t)row * DM + c) = y; }
  }
}

DEVI void phase_hg_pre(const Params& p, int l, char* smem) {
  WSP;
  TIDL;
  const bf16_t* U = (const bf16_t*)(ws_ + O_U);
  bf16_t* QT = (bf16_t*)(ws_ + O_QT); bf16_t* KC = (bf16_t*)(ws_ + O_KC); bf16_t* KT = (bf16_t*)(ws_ + O_KT); bf16_t* VT = (bf16_t*)(ws_ + O_VT);
  float* DEC = (float*)(ws_ + O_DEC); const float* lbv = (const float*)(ws_ + O_LBV);
  const int tid = tid_, h = tid >> 7, k = tid & 127;
  const float lb0 = lbv[(0 * 4 + l) * 512 + tid], lb1 = lbv[(1 * 4 + l) * 512 + tid];
  bf16_t* S = (bf16_t*)smem;
  for (int it = blockIdx.x; it < NB * 256; it += gridDim.x) {
    const int b = it >> 8, c = it & 255; const size_t row0 = (size_t)b * SEQ + c * 16;
#pragma unroll
    for (int i = 0; i < 8; ++i) { const int pz = tid + i * 512; const int r = pz >> 8, c8 = (pz & 255) * 8;
      *(u32x4*)(S + r * 2048 + c8) = *(const u32x4*)(U + (row0 + r) * LDU + C_HGQ + c8); }
    __syncthreads();
    float q[16], bc[16], kk[16];
#pragma unroll
    for (int t = 0; t < 16; ++t) q[t] = bf2f(S[t * 2048 + tid]);
    { unsigned vp[8];
#pragma unroll
      for (int t = 0; t < 16; t += 2) vp[t >> 1] = (unsigned)S[t * 2048 + 1536 + tid] | ((unsigned)S[(t + 1) * 2048 + 1536 + tid] << 16);
      bf16_t* d = VT + (((size_t)b * 4 + h) * 128 + k) * SEQ + c * 16;
      *(u32x4*)d = (u32x4){vp[0], vp[1], vp[2], vp[3]}; *(u32x4*)(d + 8) = (u32x4){vp[4], vp[5], vp[6], vp[7]}; }
    float zf[16], zb[16];
#pragma unroll
    for (int t = 0; t < 16; ++t) { zf[t] = bf2f(S[t * 2048 + 512 + tid]); zb[t] = bf2f(S[t * 2048 + 1024 + tid]); }
    __syncthreads();
#pragma unroll
    for (int dir = 0; dir < 2; ++dir) {
      const float lb = dir ? lb1 : lb0; float run = 0.f;
#pragma unroll
      for (int tt = 0; tt < 16; ++tt) { const int t = dir ? 15 - tt : tt;
        const float z = dir ? zb[t] : zf[t];
        float f = lb + (1.f - lb) * sigmoidf_(z); f = fmaxf(f, 1e-30f);
        run += __logf(f); bc[t] = run; kk[t] = 1.f - f; }
      const float tot = run;
      unsigned kp[8];
#pragma unroll
      for (int t = 0; t < 16; ++t) {
        S[((dir * 2 + 0) * 16 + t) * 512 + tid] = f2bf(q[t] * __expf(bc[t]));
        S[((dir * 2 + 1) * 16 + t) * 512 + tid] = f2bf(kk[t] * __expf(fminf(-bc[t], 80.f)));
      }
#pragma unroll
      for (int t = 0; t < 16; t += 2) kp[t >> 1] = cvt_pk_bf16(kk[t] * __expf(tot - bc[t]), kk[t + 1] * __expf(tot - bc[t + 1]));
      bf16_t* d = KT + ((((size_t)dir * NB + b) * 4 + h) * 128 + k) * SEQ + c * 16;
      *(u32x4*)d = (u32x4){kp[0], kp[1], kp[2], kp[3]}; *(u32x4*)(d + 8) = (u32x4){kp[4], kp[5], kp[6], kp[7]};
      DEC[(((size_t)dir * NB + b) * 256 + c) * 512 + tid] = __expf(tot);
    }
    __syncthreads();
#pragma unroll
    for (int i = 0; i < 8; ++i) { const int pz = tid + i * 512; const int arr = pz >> 10, r = (pz >> 6) & 15, c8 = (pz & 63) * 8;
      bf16_t* dst = ((arr & 1) ? KC : QT) + ((size_t)(arr >> 1) * NT + row0 + r) * 512 + c8;
      *(u32x4*)dst = *(const u32x4*)(S + (arr * 16 + r) * 512 + c8); }
    __syncthreads();
  }
}

DEVI void hg_scan_item(const Params& p, int item, char* smem) {
  WSP; TIDL;
  const int dir = item & 1, h = (item >> 1) & 3, b = item >> 3;
  const int w = __builtin_amdgcn_readfirstlane(tid_ >> 6), lane = tid_ & 63, fr = lane & 15, fq = lane >> 4;
  LAS char* shm = (LAS char*)smem;
  bf16_t* U = (bf16_t*)(ws_ + O_U);
  const char* QTb = (const char*)((const bf16_t*)(ws_ + O_QT) + ((size_t)dir * NT + (size_t)b * SEQ) * 512 + h * 128);
  const char* KCb = (const char*)((const bf16_t*)(ws_ + O_KC) + ((size_t)dir * NT + (size_t)b * SEQ) * 512 + h * 128);
  const char* KTb = (const char*)((const bf16_t*)(ws_ + O_KT) + (((size_t)dir * NB + b) * 4 + h) * 128 * SEQ);
  const char* VTb = (const char*)((const bf16_t*)(ws_ + O_VT) + ((size_t)b * 4 + h) * 128 * SEQ);
  const char* DECb = (const char*)((const float*)(ws_ + O_DEC) + ((size_t)dir * NB + b) * 256 * 512 + h * 128);
  const int P = (w & 3) * 64 + lane;
  const unsigned off0 = (unsigned)((P >> 4) * 1024 + (((P & 15) ^ (P >> 4)) * 16));
  const unsigned off1 = (unsigned)((P >> 1) * (SEQ * 2) + (P & 1) * 16);
  const char* g0 = (w < 4) ? QTb : KCb; const char* g1 = (w < 4) ? KTb : VTb;
  const unsigned l0 = ((w < 4) ? 0u : 4096u) + (unsigned)(w & 3) * 1024u, l1 = ((w < 4) ? 8192u : 12288u) + (unsigned)(w & 3) * 1024u;
  constexpr unsigned SLOT = 17408u;
#define HG_ISSUE(cc_, slot_) do { const int ci_ = (cc_) < 256 ? (cc_) : 255; const int c_ = dir ? 255 - ci_ : ci_; const unsigned so_ = (unsigned)(slot_) * SLOT; \
    __builtin_amdgcn_global_load_lds((const unsigned*)(g0 + (size_t)c_ * 16384 + off0), (LAS unsigned*)(shm + so_ + l0), 16, 0, 0); \
    __builtin_amdgcn_global_load_lds((const unsigned*)(g1 + (size_t)c_ * 32 + off1), (LAS unsigned*)(shm + so_ + l1), 16, 0, 0); \
    __builtin_amdgcn_global_load_lds((const unsigned*)(DECb + (size_t)c_ * 2048 + (lane & 31) * 16), (LAS unsigned*)(shm + so_ + 16384u), 16, 0, 0); } while (0)
  f32x4 st[8];
#pragma unroll
  for (int i = 0; i < 8; ++i) st[i] = (f32x4){0.f, 0.f, 0.f, 0.f};
  const int ocol = (dir ? C_OB : C_OF) + h * 128 + w * 16 + fq * 4;
  __builtin_amdgcn_s_barrier();
  for (int cc = 0; cc < 6; ++cc) HG_ISSUE(cc, cc);
  int s_cur = 0, s_iss = 6;
  const unsigned qo0 = (unsigned)(fr * 256 + (fq & 1) * 8);
#pragma nounroll
  for (int cc = 0; cc < 256; ++cc) {
    asm volatile("s_waitcnt vmcnt(15)" ::: "memory");
    __builtin_amdgcn_s_barrier();
    asm volatile("" ::: "memory");
    HG_ISSUE(cc + 6, s_iss); s_iss = (s_iss == 6) ? 0 : s_iss + 1;
    const int c = dir ? 255 - cc : cc; const size_t row0 = (size_t)b * SEQ + c * 16;
    const LAS char* sl = shm + (unsigned)s_cur * SLOT; s_cur = (s_cur == 6) ? 0 : s_cur + 1;
    bf16x8 qf[4], kf[4];
#pragma unroll
    for (int i2 = 0; i2 < 4; ++i2) {
      const unsigned pa = (unsigned)(((i2 * 4 + (fq >> 1)) ^ fr) * 16), pb = (unsigned)(((i2 * 4 + (fq >> 1) + 2) ^ fr) * 16);
      qf[i2] = cat4(*(const LAS bf16x4*)(sl + qo0 + pa), *(const LAS bf16x4*)(sl + qo0 + pb));
      kf[i2] = cat4(*(const LAS bf16x4*)(sl + 4096 + qo0 + pa), *(const LAS bf16x4*)(sl + 4096 + qo0 + pb)); }
    const bf16x4 vf = *(const LAS bf16x4*)(sl + 12288 + (w * 16 + fr) * 32 + fq * 8);
    bf16x4 ktf[8]; f32x4 dc[8];
#pragma unroll
    for (int kt = 0; kt < 8; ++kt) { ktf[kt] = *(const LAS bf16x4*)(sl + 8192 + (kt * 16 + fr) * 32 + fq * 8); dc[kt] = *(const LAS f32x4*)(sl + 16384 + (kt * 16 + fq * 4) * 4); }
    const f32x4 z4 = (f32x4){0.f, 0.f, 0.f, 0.f};
    f32x4 sca = mfma32(kf[0], qf[0], z4), scb = mfma32(kf[2], qf[2], z4);
    f32x4 oa = mfma32(pack8(st[0], st[1]), qf[0], z4), ob = mfma32(pack8(st[4], st[5]), qf[2], z4);
    sca = mfma32(kf[1], qf[1], sca); scb = mfma32(kf[3], qf[3], scb);
    oa = mfma32(pack8(st[2], st[3]), qf[1], oa); ob = mfma32(pack8(st[6], st[7]), qf[3], ob);
    f32x4 sc = sca + scb;
#pragma unroll
    for (int j = 0; j < 4; ++j) { const int s_ = fq * 4 + j, t = fr; const bool ok = dir ? (s_ >= t) : (s_ <= t); sc[j] = ok ? sc[j] : 0.f; }
    f32x4 o = mfma16(vf, pack4(sc), oa);
    o = o + ob;
    *(bf16x4*)(U + (row0 + fr) * LDU + ocol) = pack4(o);
#pragma unroll
    for (int kt = 0; kt < 8; ++kt) { st[kt] = st[kt] * dc[kt]; st[kt] = mfma16(ktf[kt], vf, st[kt]); }
  }
  asm volatile("s_waitcnt vmcnt(0)" ::: "memory");
  __syncthreads();
#undef HG_ISSUE
}

DEVI float one_minus_exp(float x) {
  return x > -0.05f ? -x * (1.f + x * (0.5f + x * (0.16666667f + x * 0.041666668f))) : 1.f - __expf(x);
}
DEVI void pre_tok64(const Params& p, int l, int item, char* smem) {
  WSP; TIDL;
  const int b = item >> 6, tile = item & 63; const int t0 = tile * 64; const size_t brow0 = (size_t)b * SEQ; const size_t row0 = brow0 + t0;
  const int tid = tid_, w = tid >> 6, lane = tid & 63, fr = lane & 15, fq = lane >> 4;
  const bf16_t* U = (const bf16_t*)(ws_ + O_U);
  bf16_t* S = (bf16_t*)smem;
  { const int t = tid >> 3, j4 = (tid & 7) * 4; const bf16x4 raw = ld4(U + (row0 + t) * LDU + C_SSDT + j4);
#pragma unroll
    for (int i = 0; i < 4; ++i) { const int cidx = j4 + i, dir = cidx >> 4, hh = cidx & 15;
      const float dt = softplusf_(bf2f((bf16_t)raw[i]) + p.in[17][(l * 2 + dir) * 16 + hh]);
      ((float*)(ws_ + O_DT))[((size_t)dir * NT + row0 + t) * 16 + hh] = dt;
      ((float*)(ws_ + O_AA))[((size_t)dir * NT + row0 + t) * 16 + hh] = -__expf(p.in[18][(l * 2 + dir) * 16 + hh]) * dt; } }
  u32x4 pre[9];
#define TOK_COL0(blk_) ((blk_) < 2 ? C_SSX + (blk_) * 512 : ((blk_) == 2 ? C_SSB : ((blk_) == 3 ? C_SSC : ((blk_) == 4 ? C_NAV : C_LRX))))
#define TOK_PREFETCH(blk_) do { const int col0_ = TOK_COL0(blk_); _Pragma("unroll") for (int it = 0; it < 9; ++it) { const int i = tid + it * 512; pre[it] = (u32x4){0u, 0u, 0u, 0u}; \
      if (i < 67 * 64) { const int r = i >> 6, c8 = (i & 63) * 8; const int tt = t0 - 2 + r; if (tt >= 0 && tt < SEQ) pre[it] = *(const u32x4*)(U + (brow0 + tt) * LDU + col0_ + c8); } } } while (0)
  TOK_PREFETCH(0);
#pragma nounroll
  for (int blk = 0; blk < 6; ++blk) {
#pragma unroll
    for (int it = 0; it < 9; ++it) { const int i = tid + it * 512; if (i < 67 * 64) { const int r = i >> 6, c8 = (i & 63) * 8; *(u32x4*)(S + r * 520 + c8) = pre[it]; } }
    __syncthreads();
    if (blk < 5) TOK_PREFETCH(blk + 1);
    float w0 = 0.f, w1 = 0.f, w2 = 1.f, w3 = 0.f, bias = 0.f;
    if (blk < 4) { const int ch = blk * 512 + tid; const float* cw = p.in[15] + (size_t)l * 4 * 2048; w0 = cw[ch]; w1 = cw[2048 + ch]; w2 = cw[4096 + ch]; w3 = cw[6144 + ch]; bias = p.in[16][(size_t)l * 2048 + ch]; }
    else if (blk == 5) { const float* cw = p.in[10] + (size_t)l * 4 * 512; w0 = cw[tid]; w1 = cw[512 + tid]; w2 = cw[1024 + tid]; w3 = cw[1536 + tid]; bias = p.in[11][l * 512 + tid]; }
    bf16_t* tdst = nullptr;
    if (blk < 2) { const int ch = blk * 512 + tid; tdst = (bf16_t*)(ws_ + O_XST) + (((size_t)b * 16 + (ch >> 6)) * 64 + (ch & 63)) * SEQ + t0; }
    else if (blk == 2) tdst = (bf16_t*)(ws_ + O_BT) + (((size_t)b * 4 + (tid >> 7)) * 128 + (tid & 127)) * SEQ + t0;
    else if (blk == 4) tdst = (bf16_t*)(ws_ + O_VTN) + (((size_t)b * 8 + (tid >> 6)) * 64 + (tid & 63)) * SEQ + t0;
    float xm2 = bf2f(S[0 * 520 + tid]), xm1 = bf2f(S[1 * 520 + tid]), x0 = bf2f(S[2 * 520 + tid]);
    for (int t8 = 0; t8 < 64; t8 += 8) { float y[8];
#pragma unroll
      for (int i = 0; i < 8; ++i) { const float x1 = bf2f(S[(t8 + i + 3) * 520 + tid]); float v = w0 * xm2 + w1 * xm1 + w2 * x0 + w3 * x1 + bias;
        if (blk < 4) v = siluf_(v);
        y[i] = v; xm2 = xm1; xm1 = x0; x0 = x1; }
      if (tdst) *(u32x4*)(tdst + t8) = (u32x4){cvt_pk_bf16(y[0], y[1]), cvt_pk_bf16(y[2], y[3]), cvt_pk_bf16(y[4], y[5]), cvt_pk_bf16(y[6], y[7])};
      if (blk == 2 || blk == 3 || blk == 5) {
#pragma unroll
        for (int i = 0; i < 8; ++i) S[(t8 + i) * 520 + tid] = f2bf(y[i]); }
    }
    __syncthreads();
    if (blk == 2 || blk == 3) {
      bf16_t* dst = (bf16_t*)(ws_ + (blk == 2 ? O_BM : O_CM));
#pragma unroll
      for (int it = 0; it < 8; ++it) { const int i = tid + it * 512; const int r = i >> 6, c8 = (i & 63) * 8;
        *(u32x4*)(dst + (row0 + r) * 512 + c8) = *(const u32x4*)(S + r * 520 + c8); }
      __syncthreads();
    }
  }
  { const bf16_t* xt = S;
    float* scr = (float*)(smem + 69888) + w * 2048;
    const bf16_t* WG = (const bf16_t*)(ws_ + O_W) + W_LRG;
    _Float16* HL = (_Float16*)(ws_ + O_HL); _Float16* PP = (_Float16*)(ws_ + O_PP);
    const int n = w;
    for (int dir = 0; dir < 2; ++dir) {
      bf16x8 wf[2][4][2];
#pragma unroll
      for (int g = 0; g < 2; ++g)
#pragma unroll
        for (int nt_ = 0; nt_ < 4; ++nt_)
#pragma unroll
          for (int ks = 0; ks < 2; ++ks) wf[g][nt_][ks] = ld8(WG + ((size_t)(nt_ * 16 + fr) * 32 + ((dir * 2 + g) * 8 + n)) * 64 + ks * 32 + fq * 8);
      float gbr[4], gbi[4], sp[4];
#pragma unroll
      for (int nt_ = 0; nt_ < 4; ++nt_) { const int ch = n * 64 + nt_ * 16 + fr;
        gbr[nt_] = p.in[13][((l * 2 + dir) * 2 + 0) * 512 + ch]; gbi[nt_] = p.in[13][((l * 2 + dir) * 2 + 1) * 512 + ch];
        sp[nt_] = softplusf_(-p.in[14][(l * 2 + dir) * 512 + ch]); }
      float hrun = 0.f, prun = 1.f;
      for (int mm = 0; mm < 4; ++mm) { const int mi = dir ? 3 - mm : mm;
        bf16x8 af[2];
#pragma unroll
        for (int ks = 0; ks < 2; ++ks) af[ks] = *(const bf16x8*)(xt + (mi * 16 + fr) * 520 + n * 64 + ks * 32 + fq * 8);
#pragma unroll
        for (int nt_ = 0; nt_ < 4; ++nt_) {
          f32x4 ar = (f32x4){0.f, 0.f, 0.f, 0.f}, ai_ = (f32x4){0.f, 0.f, 0.f, 0.f};
#pragma unroll
          for (int ks = 0; ks < 2; ++ks) { ar = mfma32(af[ks], wf[0][nt_][ks], ar); ai_ = mfma32(af[ks], wf[1][nt_][ks], ai_); }
#pragma unroll
          for (int j = 0; j < 4; ++j) { const int tl = fq * 4 + j, e = nt_ * 16 + fr;
            const float xv = bf2f(xt[(mi * 16 + tl) * 520 + n * 64 + e]);
            const float rg = sigmoidf_(ar[j] + gbr[nt_]), ig = sigmoidf_(ai_[j] + gbi[nt_]);
            const float la = -8.f * rg * sp[nt_]; const float a = __expf(la);
            const float mult = __builtin_amdgcn_sqrtf(fmaxf(one_minus_exp(2.f * la), 0.f));
            scr[tl * 64 + e] = a; scr[1024 + tl * 64 + e] = mult * ig * xv; }
        }
        __builtin_amdgcn_wave_barrier(); asm volatile("s_waitcnt lgkmcnt(0)" ::: "memory");
        for (int t2 = 0; t2 < 16; ++t2) { const int tl = dir ? 15 - t2 : t2;
          const float a = scr[tl * 64 + lane], u = scr[1024 + tl * 64 + lane];
          hrun = a * hrun + u; prun *= a;
          const size_t o = ((size_t)dir * NT + row0 + mi * 16 + tl) * 512 + n * 64 + lane;
          HL[o] = (_Float16)hrun; PP[o] = (_Float16)prun; }
        __builtin_amdgcn_wave_barrier(); asm volatile("s_waitcnt lgkmcnt(0)" ::: "memory");
      }
      const size_t co = (((size_t)dir * NB + b) * 64 + tile) * 512 + n * 64 + lane;
      ((float*)(ws_ + O_CP))[co] = prun; ((float*)(ws_ + O_CH))[co] = hrun;
    }
    __syncthreads();
  }
}

DEVI void lru_carry_item(const Params& p, int item) {
  TIDL;
  WSP;
  const int g = item * 512 + tid_; const int dir = g >> 11, b = (g >> 9) & 3, ch = g & 511;
  const float* CP = (const float*)(ws_ + O_CP); const float* CH = (const float*)(ws_ + O_CH); float* CIN = (float*)(ws_ + O_CIN);
  float run = 0.f;
  for (int i = 0; i < 64; ++i) { const int tile = dir ? 63 - i : i; const size_t o = (((size_t)dir * NB + b) * 64 + tile) * 512 + ch;
    CIN[o] = run; run = CP[o] * run + CH[o]; }
}

DEVI void ssd_diag_item(const Params& p, int l, int item, char* smem) {
  TIDL;
  WSP;
  const int n = item & 31, g = (item >> 5) & 3, b = item >> 7;
  const int tid = tid_, w = tid >> 6, lane = tid & 63, fr = lane & 15, fq = lane >> 4;
  bf16_t* U = (bf16_t*)(ws_ + O_U);
  const bf16_t* BM = (const bf16_t*)(ws_ + O_BM) + g * 128; const bf16_t* CM = (const bf16_t*)(ws_ + O_CM) + g * 128;
  float* acum = (float*)smem;
  float* dtv = acum + 1024;
  const size_t row0 = (size_t)b * SEQ + n * 128; const int tc0 = n * 128;
  {
    const int dir = w & 1, hh = g * 4 + (w >> 1);
    const float* DT = (const float*)(ws_ + O_DT) + (size_t)dir * NT * 16 + hh; const float* AA = (const float*)(ws_ + O_AA) + (size_t)dir * NT * 16 + hh;
    const float a0 = AA[(row0 + 2 * lane) * 16], a1 = AA[(row0 + 2 * lane + 1) * 16];
    const float d0 = DT[(row0 + 2 * lane) * 16], d1 = DT[(row0 + 2 * lane + 1) * 16];
    float s_ = a0 + a1, inc = s_;
    for (int o = 1; o < 64; o <<= 1) { const float t = __shfl_up(inc, o); if (lane >= o) inc += t; }
    const float total = __shfl(inc, 63); const float exc = inc - s_;
    float c0, c1;
    if (!dir) { c0 = exc + a0; c1 = exc + a0 + a1; } else { c0 = total - exc; c1 = total - exc - a0; }
    acum[w * 128 + 2 * lane] = c0 * 1.4426950408889634f; acum[w * 128 + 2 * lane + 1] = c1 * 1.4426950408889634f;
    dtv[w * 128 + 2 * lane] = d0; dtv[w * 128 + 2 * lane + 1] = d1;
  }
  int q = w * 16 + fr; asm volatile("" : "+v"(q));
  f32x4 cb[8];
  { bf16x8 cf[4];
#pragma unroll
    for (int ks = 0; ks < 4; ++ks) cf[ks] = ld8(CM + (row0 + q) * 512 + ks * 32 + fq * 8);
#pragma unroll
    for (int kt = 0; kt < 8; ++kt) { cb[kt] = (f32x4){0.f, 0.f, 0.f, 0.f};
#pragma unroll
      for (int ks = 0; ks < 4; ++ks) cb[kt] = mfma32(ld8(BM + (row0 + kt * 16 + fr) * 512 + ks * 32 + fq * 8), cf[ks], cb[kt]); } }
  __syncthreads();
#pragma nounroll
  for (int r = 0; r < 4; ++r) {
    const int hh = g * 4 + r;
    const bf16_t* XST = (const bf16_t*)(ws_ + O_XST) + ((size_t)b * 16 + hh) * 64 * SEQ;
    const float skip = p.in[19][l * 16 + hh];
    const float* acf = acum + (r * 2) * 128; const float* acb = acf + 128; const float* dtf = dtv + (r * 2) * 128; const float* dtb = dtf + 128;
    const float aqf = acf[q], aqb = acb[q];
    f32x4 y[4];
#pragma unroll
    for (int pt = 0; pt < 4; ++pt) y[pt] = (f32x4){0.f, 0.f, 0.f, 0.f};
#pragma unroll
    for (int c2 = 0; c2 < 4; ++c2) {
      f32x4 mt[2];
#pragma unroll
      for (int hf = 0; hf < 2; ++hf) { const int kt = 2 * c2 + hf; const int kb = kt * 16 + fq * 4;
        const f32x4 af = *(const f32x4*)(acf + kb), ab = *(const f32x4*)(acb + kb), df = *(const f32x4*)(dtf + kb), db = *(const f32x4*)(dtb + kb);
#pragma unroll
        for (int j = 0; j < 4; ++j) { const int k = kb + j; const bool lo = k < q;
          const float arg = lo ? (aqf - af[j]) : (aqb - ab[j]);
          float wgt_ = __builtin_amdgcn_exp2f(arg) * (lo ? df[j] : db[j]);
          wgt_ += (k == q) ? df[j] : 0.f;
          mt[hf][j] = cb[kt][j] * wgt_; } }
      const bf16x8 mf = pack8(mt[0], mt[1]);
#pragma unroll
      for (int pt = 0; pt < 4; ++pt) { const bf16_t* xp = XST + (size_t)(pt * 16 + fr) * SEQ + tc0 + c2 * 32 + fq * 4;
        y[pt] = mfma32(cat4(ld4(xp), ld4(xp + 16)), mf, y[pt]); }
    }
    const int ycol = (hh < 8 ? C_YD0 : C_YD1) + (hh & 7) * 64;
#pragma unroll
    for (int pt = 0; pt < 4; ++pt) { f32x4 v = y[pt];
#pragma unroll
      for (int j = 0; j < 4; ++j) v[j] += skip * bf2f(XST[(size_t)(pt * 16 + fq * 4 + j) * SEQ + tc0 + q]);
      *(bf16x4*)(U + (row0 + q) * LDU + ycol + pt * 16 + fq * 4) = pack4(v); }
  }
  __syncthreads();
}

DEVI void ssd_scan_item(const Params& p, int l, int item, char* smem) {
  TIDL;
  WSP;
  const int dir = item & 1, hh = (item >> 1) & 15, b = item >> 5, g = hh >> 2;
  const int tid = tid_, w = tid >> 6, lane = tid & 63, fr = lane & 15, fq = lane >> 4;
  bf16_t* U = (bf16_t*)(ws_ + O_U);
  const bf16_t* XST = (const bf16_t*)(ws_ + O_XST) + ((size_t)b * 16 + hh) * 64 * SEQ;
  const bf16_t* CM = (const bf16_t*)(ws_ + O_CM) + g * 128;
  const bf16_t* BT = (const bf16_t*)(ws_ + O_BT) + ((size_t)b * 4 + g) * 128 * SEQ;
  const float* DT = (const float*)(ws_ + O_DT) + (size_t)dir * NT * 16 + hh; const float* AA = (const float*)(ws_ + O_AA) + (size_t)dir * NT * 16 + hh;
  float* acum = (float*)smem;
  float* wgt = acum + 256;
  float* tot = wgt + 256;
  bf16_t* stl = (bf16_t*)(smem + 4096);
  for (int i = tid; i < 64 * 136; i += 512) stl[i] = 0;
  f32x4 stT[4];
#pragma unroll
  for (int i = 0; i < 4; ++i) stT[i] = (f32x4){0.f, 0.f, 0.f, 0.f};
  const int q = w * 16 + fr;
  bf16x8 cf[4]; float a0 = 0.f, a1 = 0.f, d0 = 0.f, d1 = 0.f;
#define SSD_LOADC(nn_, CF, A0, A1, D0, D1) do { const int n_ = dir ? 31 - (nn_) : (nn_); const size_t r0_ = (size_t)b * SEQ + n_ * 128; \
    _Pragma("unroll") for (int ks = 0; ks < 4; ++ks) CF[ks] = ld8(CM + (r0_ + q) * 512 + ks * 32 + fq * 8); \
    if (w == 0) { A0 = AA[(r0_ + 2 * lane) * 16]; A1 = AA[(r0_ + 2 * lane + 1) * 16]; D0 = DT[(r0_ + 2 * lane) * 16]; D1 = DT[(r0_ + 2 * lane + 1) * 16]; } } while (0)
  SSD_LOADC(0, cf, a0, a1, d0, d1);
#pragma nounroll
  for (int nn = 0; nn < 32; ++nn) {
    const int n = dir ? 31 - nn : nn, par = nn & 1; const size_t row0 = (size_t)b * SEQ + n * 128; const int tc0 = n * 128;
    bf16x8 br[4], xs[4][4];
#pragma unroll
    for (int ks = 0; ks < 4; ++ks) { br[ks] = ld8(BT + (size_t)(w * 16 + fr) * SEQ + tc0 + ks * 32 + fq * 8);
#pragma unroll
      for (int pt = 0; pt < 4; ++pt) xs[ks][pt] = ld8(XST + (size_t)(pt * 16 + fr) * SEQ + tc0 + ks * 32 + fq * 8); }
    bf16x8 cfn[4]; float a0n = 0.f, a1n = 0.f, d0n = 0.f, d1n = 0.f;
    { const int nx = nn < 31 ? nn + 1 : 31; SSD_LOADC(nx, cfn, a0n, a1n, d0n, d1n); }
    if (w == 0) {
      float s_ = a0 + a1, inc = s_;
      for (int o = 1; o < 64; o <<= 1) { const float t = __shfl_up(inc, o); if (lane >= o) inc += t; }
      const float total = __shfl(inc, 63); const float exc = inc - s_;
      float c0, c1;
      if (!dir) { c0 = exc + a0; c1 = exc + a0 + a1; } else { c0 = total - exc; c1 = total - exc - a0; }
      acum[par * 128 + 2 * lane] = c0; acum[par * 128 + 2 * lane + 1] = c1;
      wgt[par * 128 + 2 * lane] = __expf(total - c0) * d0; wgt[par * 128 + 2 * lane + 1] = __expf(total - c1) * d1;
      if (lane == 0) tot[par] = total;
    }
    __syncthreads();
    const float* ac = acum + par * 128; const float* wg = wgt + par * 128;
    const float acq = ac[q];
    f32x4 y[4];
#pragma unroll
    for (int pt = 0; pt < 4; ++pt) { y[pt] = (f32x4){0.f, 0.f, 0.f, 0.f};
#pragma unroll
      for (int ks = 0; ks < 4; ++ks) y[pt] = mfma32(*(const bf16x8*)(stl + (pt * 16 + fr) * 136 + ks * 32 + fq * 8), cf[ks], y[pt]); }
    const float eq = __expf(acq);
#pragma unroll
    for (int pt = 0; pt < 4; ++pt) *(bf16x4*)(U + (row0 + q) * LDU + (dir ? C_YSB : C_YSF) + hh * 64 + pt * 16 + fq * 4) = pack4(y[pt] * eq);
    const float et = __expf(tot[par]);
#pragma unroll
    for (int pt = 0; pt < 4; ++pt) stT[pt] = stT[pt] * et;
#pragma unroll
    for (int ks = 0; ks < 4; ++ks) {
      f32x4 lo, hi;
#pragma unroll
      for (int i = 0; i < 4; ++i) { lo[i] = bf2f((bf16_t)br[ks][i]) * wg[ks * 32 + fq * 8 + i]; hi[i] = bf2f((bf16_t)br[ks][4 + i]) * wg[ks * 32 + fq * 8 + 4 + i]; }
      const bf16x8 bw = pack8(lo, hi);
#pragma unroll
      for (int pt = 0; pt < 4; ++pt) stT[pt] = mfma32(bw, xs[ks][pt], stT[pt]);
    }
    __syncthreads();
#pragma unroll
    for (int pt = 0; pt < 4; ++pt) *(bf16x4*)(stl + (pt * 16 + fr) * 136 + w * 16 + fq * 4) = pack4(stT[pt]);
#pragma unroll
    for (int ks = 0; ks < 4; ++ks) cf[ks] = cfn[ks];
    a0 = a0n; a1 = a1n; d0 = d0n; d1 = d1n;
  }
#undef SSD_LOADC
  __syncthreads();
}

DEVI void na_item(const Params& p, int l, int item, const char* smem) {
  TIDL;
  WSP;
  const int w = tid_ >> 6, lane = tid_ & 63, fr = lane & 15, fq = lane >> 4;
  const int m = item & 3, r = (item >> 2) & 63, b = item >> 8, hd = w;
  bf16_t* U = (bf16_t*)(ws_ + O_U);
  const bf16_t* VTN = (const bf16_t*)(ws_ + O_VTN) + ((size_t)b * 8 + hd) * 64 * SEQ;
  const float* rpb = (const float*)(smem + 16384) + hd * 465;
  int kr0 = r - 4; kr0 = kr0 < 0 ? 0 : (kr0 > 56 ? 56 : kr0);
  int kc0 = m * 16 - 8; kc0 = kc0 < 0 ? 0 : (kc0 > 32 ? 32 : kc0);
  const size_t qrow = (size_t)b * SEQ + r * 64 + m * 16 + fr;
  bf16x8 qf[2];
#pragma unroll
  for (int ks = 0; ks < 2; ++ks) qf[ks] = ld8(U + qrow * LDU + C_NAQ + hd * 64 + ks * 32 + fq * 8);
  const int qcol = m * 16 + fr; int cst = qcol - 8; cst = cst < 0 ? 0 : (cst > 48 ? 48 : cst);
  f32x4 s[16]; float mx = -1e30f;
#pragma unroll
  for (int a = 0; a < 8; ++a)
#pragma unroll
    for (int hf = 0; hf < 2; ++hf) { const int ti = a * 2 + hf;
      const size_t krow = (size_t)b * SEQ + (kr0 + a) * 64 + kc0 + hf * 16 + fr;
      f32x4 acc = (f32x4){0.f, 0.f, 0.f, 0.f};
#pragma unroll
      for (int ks = 0; ks < 2; ++ks) acc = mfma32(ld8(U + krow * LDU + C_NAK + hd * 64 + ks * 32 + fq * 8), qf[ks], acc);
      const int dr = kr0 + a - r + 7;
#pragma unroll
      for (int j = 0; j < 4; ++j) { const int kcol = kc0 + hf * 16 + fq * 4 + j; const bool ok = (kcol >= cst) && (kcol < cst + 16);
        int dcc = kcol - qcol; dcc = dcc < -15 ? -15 : (dcc > 15 ? 15 : dcc);
        const float v = ok ? acc[j] * 0.125f + rpb[dr * 31 + dcc + 15] : -1e30f; acc[j] = v; mx = fmaxf(mx, v); }
      s[ti] = acc; }
  mx = fmaxf(mx, __shfl_xor(mx, 16)); mx = fmaxf(mx, __shfl_xor(mx, 32));
  float sum = 0.f;
#pragma unroll
  for (int ti = 0; ti < 16; ++ti)
#pragma unroll
    for (int j = 0; j < 4; ++j) { const float e = s[ti][j] > -1e29f ? __expf(s[ti][j] - mx) : 0.f; s[ti][j] = e; sum += e; }
  sum += __shfl_xor(sum, 16); sum += __shfl_xor(sum, 32);
  const float inv = __builtin_amdgcn_rcpf(sum);
  f32x4 o[4];
#pragma unroll
  for (int dt = 0; dt < 4; ++dt) o[dt] = (f32x4){0.f, 0.f, 0.f, 0.f};
#pragma unroll
  for (int a = 0; a < 8; ++a) { const bf16x8 pf = pack8(s[2 * a], s[2 * a + 1]);
#pragma unroll
    for (int dt = 0; dt < 4; ++dt) { const bf16_t* vp = VTN + (size_t)(dt * 16 + fr) * SEQ + (kr0 + a) * 64 + kc0 + fq * 4;
      o[dt] = mfma32(cat4(ld4(vp), ld4(vp + 16)), pf, o[dt]); } }
#pragma unroll
  for (int dt = 0; dt < 4; ++dt) *(bf16x4*)(U + qrow * LDU + C_YNA + hd * 64 + dt * 16 + fq * 4) = pack4(o[dt] * inv);
}

DEVI void phase_finalize(const Params& p, int l) {
  TIDL;
  WSP;
  const int wid = tid_ >> 6, lane = tid_ & 63;
  bf16_t* U = (bf16_t*)(ws_ + O_U);
  const _Float16* HL = (const _Float16*)(ws_ + O_HL); const _Float16* PP = (const _Float16*)(ws_ + O_PP); const float* CIN = (const float*)(ws_ + O_CIN);
  const float* hgn = p.in[8] + l * 512; const float* ssn = p.in[20] + l * 1024;
  for (int row = blockIdx.x * 8 + wid; row < NT; row += gridDim.x * 8) {
    bf16_t* ur = U + (size_t)row * LDU; const int b = row >> 12, tile = (row & 4095) >> 6;
    {
      const int c = lane * 16; float y[16], ss = 0.f;
#pragma unroll
      for (int hf = 0; hf < 2; ++hf) { const bf16x8 yf = ld8(ur + C_YSF + c + hf * 8), yb = ld8(ur + C_YSB + c + hf * 8), zz = ld8(ur + C_SSZ + c + hf * 8), yd = ld8(ur + (c < 512 ? C_YD0 + c : C_YD1 + c - 512) + hf * 8);
#pragma unroll
        for (int i = 0; i < 8; ++i) { const float v = (bf2f((bf16_t)yf[i]) + bf2f((bf16_t)yb[i]) + bf2f((bf16_t)yd[i])) * siluf_(bf2f((bf16_t)zz[i])); y[hf * 8 + i] = v; ss += v * v; } }
      ss = wave_sum(ss); const float r = rsqrtf(ss * (1.f / 1024.f) + EPS);
#pragma unroll
      for (int hf = 0; hf < 2; ++hf) { float t[8];
#pragma unroll
        for (int i = 0; i < 8; ++i) t[i] = y[hf * 8 + i] * r * ssn[c + hf * 8 + i];
        *(u32x4*)(ur + C_YSS + c + hf * 8) = (u32x4){cvt_pk_bf16(t[0], t[1]), cvt_pk_bf16(t[2], t[3]), cvt_pk_bf16(t[4], t[5]), cvt_pk_bf16(t[6], t[7])}; } }
    {
      const int c = lane * 8; const bf16x8 of = ld8(ur + C_OF + c), ob = ld8(ur + C_OB + c), gg = ld8(ur + C_HGG + c);
      float o[8], ss = 0.f;
#pragma unroll
      for (int i = 0; i < 8; ++i) { o[i] = bf2f((bf16_t)of[i]) + bf2f((bf16_t)ob[i]); ss += o[i] * o[i]; }
      ss += __shfl_xor(ss, 1); ss += __shfl_xor(ss, 2); ss += __shfl_xor(ss, 4); ss += __shfl_xor(ss, 8);
      const float r = rsqrtf(ss * (1.f / 128.f) + EPS); float y[8];
#pragma unroll
      for (int i = 0; i < 8; ++i) y[i] = o[i] * r * hgn[c + i] * siluf_(bf2f((bf16_t)gg[i]));
      *(u32x4*)(ur + C_YHG + c) = (u32x4){cvt_pk_bf16(y[0], y[1]), cvt_pk_bf16(y[2], y[3]), cvt_pk_bf16(y[4], y[5]), cvt_pk_bf16(y[6], y[7])}; }
    {
      typedef _Float16 h8 __attribute__((ext_vector_type(8)));
      const int c = lane * 8; const bf16x8 gg = ld8(ur + C_LRG + c); float y[8];
      float hs[8] = {0.f, 0.f, 0.f, 0.f, 0.f, 0.f, 0.f, 0.f};
#pragma unroll
      for (int dir = 0; dir < 2; ++dir) { const size_t o = ((size_t)dir * NT + row) * 512 + c;
        const h8 hl = *(const h8*)(HL + o), pp = *(const h8*)(PP + o);
        const float* ci = CIN + (((size_t)dir * NB + b) * 64 + tile) * 512 + c; const f32x4 c0 = *(const f32x4*)ci, c1 = *(const f32x4*)(ci + 4);
#pragma unroll
        for (int i = 0; i < 8; ++i) hs[i] += (float)hl[i] + (float)pp[i] * (i < 4 ? c0[i] : c1[i - 4]); }
#pragma unroll
      for (int i = 0; i < 8; ++i) y[i] = hs[i] * gelu_tanh(bf2f((bf16_t)gg[i]));
      *(u32x4*)(ur + C_YLR + c) = (u32x4){cvt_pk_bf16(y[0], y[1]), cvt_pk_bf16(y[2], y[3]), cvt_pk_bf16(y[4], y[5]), cvt_pk_bf16(y[6], y[7])}; }
  }
}

__global__ void __launch_bounds__(512) mk(Params p) {
  cg::grid_group grid = cg::this_grid();
  extern __shared__ __attribute__((aligned(16))) char smem[];
  LAS char* shm = (LAS char*)smem;
  volatile int& s_item = *(volatile int*)(smem + 139264 - 16);
  unsigned* bar = (unsigned*)(p.ws + O_BAR); unsigned epoch = 0; (void)epoch;
  volatile LAS unsigned* xst = (volatile LAS unsigned*)(shm + 139264 - 32);
  if (threadIdx.x == 0) { xst[0] = 0u; xst[1] = 0u; }
  __syncthreads();
  const XcdBarrier xb = xcd_barrier_post(bar, xst);
#if DIAG
  unsigned long long tprev_ = wall_clock64(); unsigned accx_ = 0, accy_ = 0;
#define TICK(i) { const unsigned long long now_ = wall_clock64(); const unsigned d_ = (unsigned)(now_ - tprev_); tprev_ = now_; if ((i) == TX) accx_ += d_; if ((i) == TY) accy_ += d_; }
#else
#define TICK(i)
#endif
  bf16_t* U = (bf16_t*)(p.ws + O_U); bf16_t* H = (bf16_t*)(p.ws + O_H); bf16_t* W = (bf16_t*)(p.ws + O_W);
  float* MF = (float*)(p.ws + O_MF32); bf16_t* HID = (bf16_t*)(p.ws + O_HID);
  const float* mod = (const float*)(p.ws + O_MOD);
  float* X = p.X;

  REP(0) {
#ifndef NO_MOD
  phase_mod(p, smem);
#endif
#ifndef NO_WCONV
  phase_wconv(p, 0, smem);
#endif
  }
  grid.sync();
  TICK(0)

  for (int l = 0; l < NL; ++l) {
    const float* modl = mod + (size_t)l * 4 * 6144;
    REP(1) {
#ifndef NO_WCONV
    if (l > 0) phase_wconv(p, l, smem);
#endif
#ifndef NO_NORM
    phase_norm(l == 0 ? p.in[0] : X, l == 0 ? X : nullptr, p.in[4] + l * DM, modl, 0, 1024, H);
#endif
    }
    gsync(bar, epoch); if ((DUP >> 20) & 1) gsync(bar, epoch); TICK(1)
    REP(2) {
#ifndef NO_GEMM1
      gemm_stream<true>(shm, DM, DM,
        [&](int i, GUnit& g) { const int u = blockIdx.x + i * (int)gridDim.x; if (u >= 64 * 49) return false; int pm, pn; tile_of(u, 64, 49, pm, pn);
          g.brow = pm * 256; g.bcol = pn * 256; g.nt = 16; g.aux = 0; g.keep = 0; g.cA = (const char*)(H + (size_t)g.brow * DM); g.cB = (const char*)(W + W_IN + (size_t)g.bcol * DM); return true; },
        [&](const GUnit& g, f32x4 (&acc)[2][2][4][2]) { const int brow = g.brow, bcol = g.bcol;
          EPI_PK( *(bf16x8*)(U + (size_t)row * LDU + col8) = pack8(v0, v1); ) });
#endif
    }
    gsync(bar, epoch); if ((DUP >> 20) & 1) gsync(bar, epoch); TICK(2)
    REP(11) {
#ifndef NO_HGPRE
    phase_hg_pre(p, l, smem);
#endif
    }
#if DIAG
    gsync(bar, epoch); if ((DUP >> 20) & 1) gsync(bar, epoch); TICK(11)
#endif
    REP(3) {
#ifndef NO_TOK64
    for (int it = blockIdx.x; it < 256; it += gridDim.x) pre_tok64(p, l, it, smem);
#endif
    }
    gsync(bar, epoch); if ((DUP >> 20) & 1) gsync(bar, epoch); TICK(3)
    { const int nb = gridDim.x;
#if DIAG
      for (int it = blockIdx.x; it < 128; it += nb) ssd_scan_item(p, l, it, smem);
      gsync(bar, epoch); if ((DUP >> 20) & 1) gsync(bar, epoch); TICK(14)
      for (int it = blockIdx.x + 128; it < 128 + 32 + 8; it += nb) {
#else
      for (int it = blockIdx.x; it < 128 + 32 + 8; it += nb) {
#endif
        if (it < 128) {
          REP(14) {
#ifndef NO_SSD
          ssd_scan_item(p, l, it, smem);
#endif
          }
        } else if (it < 160) {
          REP(12) {
#ifndef NO_HGSCAN
          hg_scan_item(p, it - 128, smem);
#endif
          }
        } else lru_carry_item(p, it - 160); }
#if DIAG
      gsync(bar, epoch); if ((DUP >> 20) & 1) gsync(bar, epoch); TICK(12)
#endif
      { float* rl = (float*)(smem + 16384); const float* rg = p.in[9] + (size_t)l * 8 * 465; __syncthreads();
        for (int i = threadIdx.x; i < 8 * 465; i += 512) rl[i] = rg[i]; __syncthreads(); }
      REP(4) { unsigned* q = bar + 16 + l + 8 * rep_;
      volatile int* slot = &s_item;
      __syncthreads(); if (threadIdx.x == 0) slot[0] = (int)atomicAdd(q, 1u); __syncthreads();
      int it = slot[0], par = 0;
      while (it < 512 + 1024) {
        if (threadIdx.x == 0) slot[par ^ 1] = (int)atomicAdd(q, 1u);
#ifndef NO_NA
        if (it < 512) ssd_diag_item(p, l, it, smem); else na_item(p, l, it - 512, smem);
#endif
        __syncthreads(); par ^= 1; it = slot[par];
      } } }
    gsync(bar, epoch); if ((DUP >> 20) & 1) gsync(bar, epoch); TICK(4)
    REP(5) {
#ifndef NO_FIN
    phase_finalize(p, l);
#endif
    }
    gsync(bar, epoch); if ((DUP >> 20) & 1) gsync(bar, epoch); TICK(5)
    REP(6) {
#ifndef NO_GEMM2
      gemm_stream<true>(shm, LDU, DM,
        [&](int i, GUnit& g) { const int u = blockIdx.x + (i >> 2) * (int)gridDim.x, seg = i & 3; if (u >= 64 * 4) return false; int pm, pn; tile_of(u, 64, 4, pm, pn);
          g.brow = pm * 256; g.bcol = pn * 256; g.nt = seg == 3 ? 16 : 8; g.aux = seg; g.keep = seg < 3;
          const int acol = seg == 0 ? C_YHG : (seg == 1 ? C_YNA : (seg == 2 ? C_YLR : C_YSS));
          g.cA = (const char*)(U + (size_t)g.brow * LDU + acol); g.cB = (const char*)(W + W_BRHG + (size_t)seg * 1024 * 1024 + (size_t)g.bcol * DM); return true; },
        [&](const GUnit& g, f32x4 (&acc)[2][2][4][2]) { const int brow = g.brow, bcol = g.bcol, seg = g.aux;
          if (seg < 3) {
#pragma unroll
            for (int ai = 0; ai < 2; ++ai)
#pragma unroll
              for (int m = 0; m < 4; ++m) { TIDL; const int wid = __builtin_amdgcn_readfirstlane(tid_ >> 6), lane = tid_ & 63, wr = wid >> 2, wc = wid & 3, fr = lane & 15, fq = lane >> 4;
                int row = brow + ai * 128 + wr * 64 + m * 16 + fr; asm volatile("" : "+v"(row));
                bf16x4 ga[4], gb[4];
#pragma unroll
                for (int bj = 0; bj < 2; ++bj)
#pragma unroll
                  for (int n = 0; n < 2; ++n) { const int col = bcol + bj * 128 + wc * 32 + fq * 8 + n * 4;
                    ga[bj * 2 + n] = ld4(U + (size_t)row * LDU + C_MRG + seg * 1024 + col); gb[bj * 2 + n] = ld4(U + (size_t)row * LDU + C_MRG + (seg + 1) * 1024 + col); }
#pragma unroll
                for (int bj = 0; bj < 2; ++bj)
#pragma unroll
                  for (int n = 0; n < 2; ++n)
#pragma unroll
                    for (int j = 0; j < 4; ++j) { const float za = bf2f((bf16_t)ga[bj * 2 + n][j]), zb = bf2f((bf16_t)gb[bj * 2 + n][j]);
                      acc[ai][bj][m][n][j] *= (1.f + __expf(fminf(-zb, 60.f))) * __builtin_amdgcn_rcpf(1.f + __expf(fminf(-za, 60.f))); }
                asm volatile("" ::: "memory"); }
          } else {
            EPI_PK( const bf16x8 gz = ld8(U + (size_t)row * LDU + C_MRG + 3 * 1024 + col8); f32x4 r0; f32x4 r1;
              for (int j = 0; j < 4; ++j) { r0[j] = v0[j] * sigmoidf_(bf2f((bf16_t)gz[j])); r1[j] = v1[j] * sigmoidf_(bf2f((bf16_t)gz[4 + j])); }
              *(bf16x8*)(H + (size_t)row * DM + col8) = pack8(r0, r1); )
          } });
#endif
    }
    gsync(bar, epoch); if ((DUP >> 20) & 1) gsync(bar, epoch); TICK(6)
#ifndef NO_GEMM3
    gemm_stream<true>(shm, DM, DM,
      [&](int i, GUnit& g) { const int u = blockIdx.x + i * (int)gridDim.x; if (u >= 64 * 4) return false; int pm, pn; tile_of(u, 64, 4, pm, pn);
        g.brow = pm * 256; g.bcol = pn * 256; g.nt = 16; g.aux = 0; g.keep = 0; g.cA = (const char*)(H + (size_t)g.brow * DM); g.cB = (const char*)(W + W_OUT + (size_t)g.bcol * DM); return true; },
      [&](const GUnit& g, f32x4 (&acc)[2][2][4][2]) { const int brow = g.brow, bcol = g.bcol;
        epi_loop2<2, true>(acc, brow, bcol,
          [&](int row, int col) -> f32x4 { return *(const f32x4*)(X + (size_t)row * DM + col); },
          [&](int row, int col, f32x4 v, f32x4 L) { const f32x4 gt = *(const f32x4*)(modl + (row >> 12) * 6144 + 2048 + col); *(f32x4*)(X + (size_t)row * DM + col) = L + gt * v; }); });
#endif
    gsync(bar, epoch); if ((DUP >> 20) & 1) gsync(bar, epoch); TICK(7)
    REP(8) {
#ifndef NO_NORM
    phase_norm(X, nullptr, p.in[5] + l * DM, modl, 3072, 4096, H);
#endif
    }
    gsync(bar, epoch); if ((DUP >> 20) & 1) gsync(bar, epoch); TICK(8)
    REP(9) {
#ifndef NO_GEMM4
      gemm_stream<true>(shm, DM, DM,
        [&](int i, GUnit& g) { const int u = blockIdx.x + i * (int)gridDim.x; if (u >= 64 * 16) return false; int pm, pn; tile_of(u, 64, 16, pm, pn);
          g.brow = pm * 256; g.bcol = pn * 256; g.nt = 16; g.aux = 0; g.keep = 0; g.cA = (const char*)(H + (size_t)g.brow * DM); g.cB = (const char*)(W + W_FF1 + (size_t)g.bcol * DM); return true; },
        [&](const GUnit& g, f32x4 (&acc)[2][2][4][2]) { const int brow = g.brow, bcol = g.bcol;
          EPI_PK( f32x4 r0; f32x4 r1; for (int j = 0; j < 4; ++j) { const float t0 = fmaxf(v0[j], 0.f); const float t1 = fmaxf(v1[j], 0.f); r0[j] = t0 * t0; r1[j] = t1 * t1; }
            *(bf16x8*)(HID + (size_t)row * DFF + col8) = pack8(r0, r1); ) });
#endif
    }
    gsync(bar, epoch); if ((DUP >> 20) & 1) gsync(bar, epoch); TICK(9)
#ifndef NO_GEMM5
    gemm_stream<true>(shm, DFF, DFF,
      [&](int i, GUnit& g) { const int u = blockIdx.x + i * (int)gridDim.x; if (u >= 64 * 4) return false; int pm, pn; tile_of(u, 64, 4, pm, pn);
        g.brow = pm * 256; g.bcol = pn * 256; g.nt = 64; g.aux = 0; g.keep = 0; g.cA = (const char*)(HID + (size_t)g.brow * DFF); g.cB = (const char*)(W + W_FF2 + (size_t)g.bcol * DFF); return true; },
      [&](const GUnit& g, f32x4 (&acc)[2][2][4][2]) { const int brow = g.brow, bcol = g.bcol;
        epi_loop2<2, true>(acc, brow, bcol,
          [&](int row, int col) -> f32x4 { return *(const f32x4*)(X + (size_t)row * DM + col); },
          [&](int row, int col, f32x4 v, f32x4 L) { const f32x4 gt = *(const f32x4*)(modl + (row >> 12) * 6144 + 5120 + col); *(f32x4*)(X + (size_t)row * DM + col) = L + gt * v; }); });
#endif
    gsync(bar, epoch); if ((DUP >> 20) & 1) gsync(bar, epoch); TICK(10)
  }
#ifndef NO_NORM
  phase_final_norm(X, p.in[28]);
#endif
#if DIAG
  if (blockIdx.x == 0 && threadIdx.x == 0) { bar[32] = accx_; bar[33] = accy_; }
  gsync(bar, epoch);
  { const float vx = (float)bar[32] * 0.01f, vy = (float)bar[33] * 0.01f;
    for (size_t i = (size_t)blockIdx.x * 512 + threadIdx.x; i < (size_t)NT * DM; i += (size_t)gridDim.x * 512) X[i] = vy;
    gsync(bar, epoch);
    if (blockIdx.x == 0 && threadIdx.x == 0) X[0] = 10.f * vx; }
#endif
}

extern "C" void kernel_launch(void* const* d_in, const int* in_sizes, int n_in, void* d_out, int out_size,
                              void* d_ws, size_t ws_size, hipStream_t stream) {
  constexpr size_t kDynLds = 136 * 1024;
  static int grid_blocks = 0;
  if (!grid_blocks) {
    int dev = 0, cus = 0, per_cu = 0;
    (void)hipGetDevice(&dev);
    (void)hipDeviceGetAttribute(&cus, hipDeviceAttributeMultiprocessorCount, dev);
    (void)hipFuncSetAttribute((const void*)mk, hipFuncAttributeMaxDynamicSharedMemorySize, (int)kDynLds);
    (void)hipOccupancyMaxActiveBlocksPerMultiprocessor(&per_cu, mk, 512, kDynLds);
    if (per_cu < 1) per_cu = 1;
    grid_blocks = cus;
  }
  Params p{};
  for (int i = 0; i < 29; ++i) p.in[i] = (const float*)d_in[i];
  p.X = (float*)d_out; p.ws = (char*)d_ws;
  (void)hipMemsetAsync(d_ws, 0, 16384, stream);
  void* args[] = {&p};
  hipError_t e = hipLaunchCooperativeKernel((void*)mk, dim3(grid_blocks), dim3(512), args, kDynLds, stream);
  if (e != hipSuccess) fprintf(stderr, "cooperative launch failed: %s (grid %d)\n", hipGetErrorString(e), grid_blocks);
}
```
